# Optimizing an MI355X kernel written in HIP

```python
import jax, jax.numpy as jnp
from jax import lax
import numpy as np

D_MODEL = 1024
BATCH = 8
SEQ = 2048
DEPTH = 2

CHUNK = 64
Q_BLOCK = 2 * CHUNK
D_MIX = D_MODEL
D_CONV = D_MIX // 4
D_POOL = D_MIX // 4
D_ATTN = D_MIX // 2
N_HEADS = 8
HEAD_DIM = D_ATTN // N_HEADS
CONV_K = 31
POOL_WINDOWS = (2, 4, 8, 16)
N_POOL_GROUPS = len(POOL_WINDOWS)
POOL_GROUP = D_POOL // N_POOL_GROUPS
D_FF = ((8 * D_MODEL // 3 + 127) // 128) * 128
FFN_CONV_K = 3
D_IN = 2 * D_CONV + D_POOL + 3 * D_ATTN
EPS = 1e-6

kernel_name = "hybrid_conv_pool_stickbreak_block"


def rmsnorm(x, g):
    xf = x.astype(jnp.float32)
    y = xf * lax.rsqrt(jnp.mean(xf * xf, axis=-1, keepdims=True) + EPS)
    return (y * g.astype(jnp.float32)).astype(x.dtype)


def layernorm(x, g, b):
    xf = x.astype(jnp.float32)
    mu = jnp.mean(xf, axis=-1, keepdims=True)
    var = jnp.mean(jnp.square(xf - mu), axis=-1, keepdims=True)
    y = (xf - mu) * lax.rsqrt(var + EPS)
    return (y * g.astype(jnp.float32) + b.astype(jnp.float32)).astype(x.dtype)


def causal_dwconv(x, w, b):
    k, c = w.shape
    y = lax.conv_general_dilated(
        x, w[:, None, :].astype(x.dtype), window_strides=(1,), padding=[(k - 1, 0)],
        dimension_numbers=("NWC", "WIO", "NWC"), feature_group_count=c)
    return y + b.astype(x.dtype)


def conformer_conv(a, gate, dw_w, dw_b, ln_g, ln_b, pw_w, pw_b):
    u = a * jax.nn.sigmoid(gate)
    u = causal_dwconv(u, dw_w, dw_b)
    u = jax.nn.silu(layernorm(u, ln_g, ln_b))
    return u @ pw_w + pw_b


def multiscale_pool(u, w, scale):
    b, s, _ = u.shape
    uf = u.astype(jnp.float32)
    cs = jnp.cumsum(uf, axis=1)
    count = jnp.arange(1, s + 1, dtype=jnp.float32)[None, :, None]
    groups = []
    for g, win in enumerate(POOL_WINDOWS):
        sl = slice(g * POOL_GROUP, (g + 1) * POOL_GROUP)
        c = cs[..., sl]
        lag = jnp.pad(c, ((0, 0), (win, 0), (0, 0)))[:, :s]
        groups.append((c - lag) / jnp.minimum(count, float(win)) - uf[..., sl])
    p = jnp.stack(groups, axis=2).astype(u.dtype)
    y = jnp.einsum("bsgc,gcd->bsgd", p, w).reshape(b, s, D_POOL)
    return y * scale


def stick_breaking_attention(q, k, v):
    s_len = q.shape[2]
    scale = HEAD_DIM ** -0.5
    outs = []
    for i0 in range(0, s_len, Q_BLOCK):
        kv = i0 + Q_BLOCK
        z = jnp.einsum("bhqd,bhkd->bhqk", q[:, :, i0:kv], k[:, :, :kv]).astype(jnp.float32) * scale
        t_pos = i0 + jnp.arange(Q_BLOCK)[:, None]
        s_pos = jnp.arange(kv)[None, :]
        mask = s_pos < t_pos
        log_keep = jnp.where(mask, jax.nn.log_sigmoid(-z), 0.0)
        log_stick = lax.cumsum(log_keep, axis=3, reverse=True) - log_keep
        a = jnp.where(mask, jnp.exp(jax.nn.log_sigmoid(z) + log_stick), 0.0)
        outs.append(jnp.einsum("bhqk,bhkd->bhqd", a.astype(v.dtype), v[:, :, :kv]))
    return jnp.concatenate(outs, axis=2)


def setup_inputs(seed: int = 0) -> dict:
    key = jax.random.key(seed)
    ks = jax.random.split(key, 20)
    f32 = jnp.float32
    nrm = lambda k, shape, s: jax.random.normal(k, shape, f32) * s
    return {
        "x": jax.random.normal(ks[0], (BATCH, SEQ, D_MODEL), f32),
        "norm1_g": 1.0 + nrm(ks[1], (DEPTH, D_MODEL), 0.05),
        "w_in": nrm(ks[2], (DEPTH, D_MODEL, D_IN), D_MODEL ** -0.5),
        "conv_dw_w": nrm(ks[3], (DEPTH, CONV_K, D_CONV), CONV_K ** -0.5),
        "conv_dw_b": nrm(ks[4], (DEPTH, D_CONV), 0.02),
        "conv_ln_g": 1.0 + nrm(ks[5], (DEPTH, D_CONV), 0.05),
        "conv_ln_b": nrm(ks[6], (DEPTH, D_CONV), 0.02),
        "conv_pw_w": nrm(ks[7], (DEPTH, D_CONV, D_CONV), D_CONV ** -0.5),
        "conv_pw_b": nrm(ks[8], (DEPTH, D_CONV), 0.02),
        "pool_w": nrm(ks[9], (DEPTH, N_POOL_GROUPS, POOL_GROUP, POOL_GROUP), POOL_GROUP ** -0.5),
        "pool_scale": 1.0 + nrm(ks[10], (DEPTH, D_POOL), 0.1),
        "w_out": nrm(ks[11], (DEPTH, D_MIX, D_MODEL), D_MIX ** -0.5),
        "norm2_g": 1.0 + nrm(ks[12], (DEPTH, D_MODEL), 0.05),
        "ffn_up": nrm(ks[13], (DEPTH, D_MODEL, 2 * D_FF), D_MODEL ** -0.5),
        "ffn_dw_w": nrm(ks[14], (DEPTH, FFN_CONV_K, D_FF), FFN_CONV_K ** -0.5),
        "ffn_dw_b": nrm(ks[15], (DEPTH, D_FF), 0.02),
        "ffn_down": nrm(ks[16], (DEPTH, D_FF, D_MODEL), D_FF ** -0.5),
        "final_g": 1.0 + nrm(ks[17], (D_MODEL,), 0.05),
    }


def reference(x, norm1_g, w_in, conv_dw_w, conv_dw_b, conv_ln_g, conv_ln_b, conv_pw_w,
              conv_pw_b, pool_w, pool_scale, w_out, norm2_g, ffn_up, ffn_dw_w, ffn_dw_b,
              ffn_down, final_g):
    b, s, _ = x.shape
    split_at = np.cumsum([D_CONV, D_CONV, D_POOL, D_ATTN, D_ATTN]).tolist()
    for l in range(DEPTH):
        h = rmsnorm(x, norm1_g[l])
        proj = h @ w_in[l]
        c_a, c_g, p_in, q, k, v = jnp.split(proj, split_at, axis=-1)
        y_conv = conformer_conv(c_a, c_g, conv_dw_w[l], conv_dw_b[l], conv_ln_g[l],
                                conv_ln_b[l], conv_pw_w[l], conv_pw_b[l])
        y_pool = multiscale_pool(p_in, pool_w[l], pool_scale[l])
        heads = lambda t: t.reshape(b, s, N_HEADS, HEAD_DIM).transpose(0, 2, 1, 3)
        y_attn = stick_breaking_attention(heads(q), heads(k), heads(v))
        y_attn = y_attn.transpose(0, 2, 1, 3).reshape(b, s, D_ATTN)
        mix = jnp.concatenate([y_conv, y_pool, y_attn], axis=-1)
        x = x + mix @ w_out[l]
        h2 = rmsnorm(x, norm2_g[l])
        val, gate = jnp.split(h2 @ ffn_up[l], 2, axis=-1)
        gate = jax.nn.gelu(causal_dwconv(gate, ffn_dw_w[l], ffn_dw_b[l]), approximate=False)
        x = x + (val * gate) @ ffn_down[l]
    return rmsnorm(x, final_g)
```

```cpp
#include <hip/hip_runtime.h>
#include <cstdint>
#include <cstdio>

typedef unsigned short bf16;
typedef short bf16x8 __attribute__((ext_vector_type(8)));
typedef float f32x4 __attribute__((ext_vector_type(4)));
typedef float f32x16 __attribute__((ext_vector_type(16)));
typedef unsigned u32x4 __attribute__((ext_vector_type(4)));
typedef unsigned u32x2 __attribute__((ext_vector_type(2)));

constexpr int D = 1024, BATCH = 8, SEQ = 2048, DEPTH = 2, M = BATCH * SEQ;
constexpr int DCONV = 256, DPOOL = 256, DATT = 512, NH = 8, HD = 64, CONVK = 31, DFF = 2816, DIN = 2304, DUP = 2 * DFF;
constexpr float EPS = 1e-6f;

constexpr size_t MiB = 1u << 20;
constexpr size_t WS_SMALL = 1 * MiB;
constexpr size_t WS_WIN = 2 * MiB;
constexpr size_t WS_WOUT = 11 * MiB;
constexpr size_t WS_WUP = 15 * MiB;
constexpr size_t WS_WDN = 37 * MiB;
constexpr size_t WS_XB = 48 * MiB;
constexpr size_t WS_R = 80 * MiB;
constexpr size_t WS_PROJ = WS_R;
constexpr size_t WS_U = WS_R + 72 * MiB;
constexpr size_t WS_MIX = WS_R + 80 * MiB;
constexpr size_t WS_H = WS_R;
constexpr size_t WS_RAW = WS_R + 88 * MiB;
constexpr size_t WS_END = WS_RAW + 44 * MiB;
static_assert(WS_END <= 256 * MiB, "ws");

__device__ __forceinline__ unsigned f2bf(float f) { unsigned u = __builtin_bit_cast(unsigned, f); return (u + 0x7fffu + ((u >> 16) & 1u)) >> 16; }
__device__ __forceinline__ float bf2f(unsigned short b) { return __builtin_bit_cast(float, (unsigned)b << 16); }
__device__ __forceinline__ float wave_sum(float v) {
#pragma unroll
    for (int o = 1; o < 64; o <<= 1) v += __shfl_xor(v, o);
    return v;
}

__device__ __forceinline__ int map_in(int n) { const int t = n >> 8, j = n & 255; return (t < 2) ? ((j < 128) ? 128 * t + j : 256 + 128 * t + (j - 128)) : n; }
__device__ __forceinline__ int map_up(int n) { const int t = n >> 8, j = n & 255; return (j < 128) ? 128 * t + j : DFF + 128 * t + (j - 128); }

template <int MAP>
__global__ __launch_bounds__(256) void k_wconv(const float* __restrict__ W, int K, int Nin, int Nout, const float* __restrict__ g, bf16* __restrict__ WT) {
    __shared__ float t[64][65];
    const int l = blockIdx.z; W += (size_t)l * K * Nin; WT += (size_t)l * Nout * K; if (g) g += (size_t)l * K;
    const int n0 = blockIdx.x * 64, k0 = blockIdx.y * 64, tid = threadIdx.x;
    const int nn = tid & 63; const int src = MAP == 1 ? map_in(n0 + nn) : (MAP == 2 ? map_up(n0 + nn) : n0 + nn);
#pragma unroll
    for (int i = 0; i < 16; ++i) { const int kk = i * 4 + (tid >> 6); float v = W[(size_t)(k0 + kk) * Nin + src]; if (g) v *= g[k0 + kk]; t[kk][nn] = v; }
    __syncthreads();
#pragma unroll
    for (int i = 0; i < 16; ++i) { const int n = i * 4 + (tid >> 6), kk = tid & 63; WT[(size_t)(n0 + n) * K + k0 + kk] = (bf16)f2bf(t[kk][n]); }
}
__global__ __launch_bounds__(256) void k_wout(const float* __restrict__ w_out, const float* __restrict__ pw_w, const float* __restrict__ pool_w, const float* __restrict__ pool_scale, bf16* __restrict__ WoT) {
    __shared__ float t[16][65];
    const int l = blockIdx.z; w_out += (size_t)l * D * D; pw_w += (size_t)l * DCONV * DCONV; pool_w += (size_t)l * 4 * 64 * 64; pool_scale += (size_t)l * DPOOL; WoT += (size_t)l * D * D;
    const int n0 = blockIdx.x * 64, k0 = blockIdx.y * 16, tid = threadIdx.x, nn = tid & 63, kq = tid >> 6;
#pragma unroll
    for (int i = 0; i < 4; ++i) {
        const int k = k0 + kq + 4 * i; float acc = 0.f;
        if (k < 256) { for (int j = 0; j < 256; ++j) acc += pw_w[k * 256 + j] * w_out[(size_t)j * D + n0 + nn]; }
        else if (k < 512) { const int g = (k - 256) >> 6, c = (k - 256) & 63; for (int d = 0; d < 64; ++d) acc += pool_w[(g * 64 + c) * 64 + d] * pool_scale[64 * g + d] * w_out[(size_t)(256 + 64 * g + d) * D + n0 + nn]; }
        else acc = w_out[(size_t)k * D + n0 + nn];
        t[kq + 4 * i][nn] = acc;
    }
    __syncthreads();
    { const int n = tid >> 2, kk = (tid & 3) * 4;
#pragma unroll
      for (int j = 0; j < 4; ++j) WoT[(size_t)(n0 + n) * D + k0 + kk + j] = (bf16)f2bf(t[kk + j][n]); }
}
__global__ __launch_bounds__(256) void k_biasout(const float* __restrict__ w_out, const float* __restrict__ pw_b, float* __restrict__ bo) {
    const int l = blockIdx.y, n = blockIdx.x * 256 + threadIdx.x; float acc = 0.f;
    for (int j = 0; j < 256; ++j) acc += pw_b[l * 256 + j] * w_out[(size_t)l * D * D + (size_t)j * D + n];
    bo[l * D + n] = acc;
}
__global__ __launch_bounds__(256) void k_xprep(const float* __restrict__ x, bf16* __restrict__ XB, float* __restrict__ SS) {
    const int row = blockIdx.x * 4 + (threadIdx.x >> 6), lane = threadIdx.x & 63;
    const f32x4* xr = (const f32x4*)(x + (size_t)row * D) + lane; float s = 0.f; u32x2* o = (u32x2*)(XB + (size_t)row * D) + lane;
#pragma unroll
    for (int j = 0; j < 4; ++j) { const f32x4 v = xr[64 * j]; s += (v.x * v.x + v.y * v.y) + (v.z * v.z + v.w * v.w); u32x2 w; w.x = f2bf(v.x) | (f2bf(v.y) << 16); w.y = f2bf(v.z) | (f2bf(v.w) << 16); o[64 * j] = w; }
    s = wave_sum(s); if (lane == 0) SS[row] = s;
}
__global__ __launch_bounds__(256) void k_rowss(const float* __restrict__ x, float* __restrict__ SS) {
    const int row = blockIdx.x * 4 + (threadIdx.x >> 6), lane = threadIdx.x & 63;
    const f32x4* xr = (const f32x4*)(x + (size_t)row * D) + lane; float s = 0.f;
#pragma unroll
    for (int j = 0; j < 4; ++j) { const f32x4 v = xr[64 * j]; s += (v.x * v.x + v.y * v.y) + (v.z * v.z + v.w * v.w); }
    s = wave_sum(s); if (lane == 0) SS[row] = s;
}
__global__ __launch_bounds__(256) void k_final(float* __restrict__ x, const float* __restrict__ g) {
    const int row = blockIdx.x * 4 + (threadIdx.x >> 6), lane = threadIdx.x & 63;
    f32x4* xr = (f32x4*)(x + (size_t)row * D) + lane; const f32x4* gr = (const f32x4*)g + lane; float s = 0.f; f32x4 v[4];
#pragma unroll
    for (int j = 0; j < 4; ++j) { v[j] = xr[64 * j]; s += (v[j].x * v[j].x + v[j].y * v[j].y) + (v[j].z * v[j].z + v[j].w * v[j].w); }
    s = wave_sum(s); const float r = 1.0f / sqrtf(s * (1.0f / D) + EPS);
#pragma unroll
    for (int j = 0; j < 4; ++j) { const f32x4 gg = gr[64 * j]; xr[64 * j] = v[j] * r * gg; }
}

struct EpiRowScaleBf16 { bf16* O; int ldc; const float* ss;
    __device__ __forceinline__ void operator()(int m, int n, float v) const { const float r = 1.0f / sqrtf(ss[m] * (1.0f / D) + EPS); O[(size_t)m * ldc + n] = (bf16)f2bf(v * r); } };
struct EpiResid { const float* xin; float* xout; bf16* XB; const float* bias;
    __device__ __forceinline__ void operator()(int m, int n, float v) const { float x = xin[(size_t)m * D + n] + v; if (bias) x += bias[n]; xout[(size_t)m * D + n] = x; XB[(size_t)m * D + n] = (bf16)f2bf(x); } };
template <class Epi>
__global__ __launch_bounds__(256) void k_gemm(const bf16* __restrict__ A, const bf16* __restrict__ Bt, int K, Epi E) {
    const int tid = threadIdx.x, wid = tid >> 6, lane = tid & 63, r32 = lane & 31, hi = lane >> 5;
    const int m0 = blockIdx.y * 128 + (wid >> 1) * 64, n0 = blockIdx.x * 128 + (wid & 1) * 64;
    f32x16 acc[2][2];
#pragma unroll
    for (int i = 0; i < 2; ++i)
#pragma unroll
        for (int j = 0; j < 2; ++j)
#pragma unroll
            for (int r = 0; r < 16; ++r) acc[i][j][r] = 0.f;
    const bf16* a0 = A + (size_t)(m0 + r32) * K + hi * 8; const bf16* b0 = Bt + (size_t)(n0 + r32) * K + hi * 8;
    for (int k = 0; k < K; k += 16) {
        bf16x8 a[2], b[2];
#pragma unroll
        for (int i = 0; i < 2; ++i) { a[i] = *(const bf16x8*)(a0 + (size_t)i * 32 * K + k); b[i] = *(const bf16x8*)(b0 + (size_t)i * 32 * K + k); }
#pragma unroll
        for (int i = 0; i < 2; ++i)
#pragma unroll
            for (int j = 0; j < 2; ++j) acc[i][j] = __builtin_amdgcn_mfma_f32_32x32x16_bf16(a[i], b[j], acc[i][j], 0, 0, 0);
    }
#pragma unroll
    for (int i = 0; i < 2; ++i)
#pragma unroll
        for (int j = 0; j < 2; ++j)
#pragma unroll
            for (int r = 0; r < 16; ++r) { const int m = m0 + 32 * i + (r & 3) + 8 * (r >> 2) + 4 * hi, n = n0 + 32 * j + r32; E(m, n, acc[i][j][r]); }
}

__global__ __launch_bounds__(256) void k_glu(const bf16* __restrict__ P, bf16* __restrict__ U) {
    const int m = blockIdx.x, c = threadIdx.x, t = c >> 7, j = c & 127;
    const float a = bf2f(P[(size_t)m * DIN + 256 * t + j]), g = bf2f(P[(size_t)m * DIN + 256 * t + 128 + j]);
    U[(size_t)m * DCONV + c] = (bf16)f2bf(a / (1.0f + __expf(-g)));
}
constexpr int CP_LDS = 94 * 256 * 2 + 64 * 256 * 4;
__global__ __launch_bounds__(512) void k_convpool(const bf16* __restrict__ U, const bf16* __restrict__ P, const float* __restrict__ dw_w, const float* __restrict__ dw_b, const float* __restrict__ ln_g, const float* __restrict__ ln_b, bf16* __restrict__ MIX) {
    extern __shared__ __attribute__((aligned(16))) unsigned char lds[];
    bf16* Ul = (bf16*)lds; float* Y = (float*)(lds + 94 * 256 * 2);
    const int tid = threadIdx.x, t0 = blockIdx.x * 64, tl = t0 % SEQ;
    for (int i = tid; i < 94 * 32; i += 512) { const int r = i >> 5, ch = i & 31; const int tok = tl - 30 + r; u32x4 v = {0u, 0u, 0u, 0u};
        if (tok >= 0) v = *(const u32x4*)(U + (size_t)(t0 - 30 + r) * DCONV + ch * 8); *(u32x4*)(Ul + r * 256 + ch * 8) = v; }
    __syncthreads();
    const int c = tid & 255, half = tid >> 8;
    { float w[CONVK];
#pragma unroll
      for (int i = 0; i < CONVK; ++i) w[i] = dw_w[i * DCONV + c];
      const float bb = dw_b[c];
      for (int g = 0; g < 8; ++g) { const int tb = half * 32 + g * 4; float in[34];
#pragma unroll
          for (int i = 0; i < 34; ++i) in[i] = bf2f(Ul[(tb + i) * 256 + c]);
#pragma unroll
          for (int q = 0; q < 4; ++q) { float acc = bb;
#pragma unroll
              for (int i = 0; i < CONVK; ++i) acc += w[i] * in[q + i];
              Y[(tb + q) * 256 + c] = acc; } } }
    __syncthreads();
    { const int wv = tid >> 6, lane = tid & 63; const f32x4 gg = ((const f32x4*)ln_g)[lane], bbv = ((const f32x4*)ln_b)[lane];
      for (int q = 0; q < 8; ++q) { const int t = wv * 8 + q; f32x4 y = ((const f32x4*)(Y + t * 256))[lane];
          const float mu = wave_sum((y.x + y.y) + (y.z + y.w)) * (1.0f / 256.0f); y = y - mu;
          const float var = wave_sum((y.x * y.x + y.y * y.y) + (y.z * y.z + y.w * y.w)) * (1.0f / 256.0f); const float rs = 1.0f / sqrtf(var + EPS);
          f32x4 z = y * rs * gg + bbv; z.x = z.x / (1.0f + __expf(-z.x)); z.y = z.y / (1.0f + __expf(-z.y)); z.z = z.z / (1.0f + __expf(-z.z)); z.w = z.w / (1.0f + __expf(-z.w));
          u32x2 o; o.x = f2bf(z.x) | (f2bf(z.y) << 16); o.y = f2bf(z.z) | (f2bf(z.w) << 16); *(u32x2*)(MIX + (size_t)(t0 + t) * D + 4 * lane) = o; } }
    { const int win = 2 << (c >> 6); const bf16* pc = P + 512 + c; float s = 0.f; const int tb = tl + half * 32;
      for (int j = 1; j < win; ++j) if (tb - j >= 0) s += bf2f(pc[(size_t)(t0 + half * 32 - j) * DIN]);
      for (int q = 0; q < 32; ++q) { const int tloc = tb + q; const size_t row = (size_t)(t0 + half * 32 + q); const float p = bf2f(pc[row * DIN]); s += p;
          const int cnt = (tloc + 1 < win) ? tloc + 1 : win; const float o = s / (float)cnt - p; MIX[row * D + 256 + c] = (bf16)f2bf(o);
          if (tloc - win + 1 >= 0) s -= bf2f(pc[(row - (size_t)(win - 1)) * DIN]); } }
}
__global__ __launch_bounds__(64) void k_attn(const bf16* __restrict__ P, bf16* __restrict__ MIX) {
    const int lane = threadIdx.x, t = blockIdx.x * 64 + lane, h = blockIdx.y, b = blockIdx.z;
    const bf16* base = P + (size_t)b * SEQ * DIN; float q[HD], o[HD];
    { const bf16* qp = base + (size_t)t * DIN + 768 + h * HD;
#pragma unroll
      for (int d = 0; d < HD; ++d) { q[d] = bf2f(qp[d]) * 0.125f; o[d] = 0.f; } }
    float carry = 0.f;
    for (int s = blockIdx.x * 64 + 62; s >= 0; --s) {
        const bf16* kp = base + (size_t)s * DIN + 1280 + h * HD; const bf16* vp = base + (size_t)s * DIN + 1792 + h * HD;
        float z = 0.f;
#pragma unroll
        for (int d = 0; d < HD; ++d) z += q[d] * bf2f(kp[d]);
        const float sp = fmaxf(z, 0.f) + log1pf(expf(-fabsf(z)));
        if (s < t) { carry += sp; const float a = expf(z - carry);
#pragma unroll
            for (int d = 0; d < HD; ++d) o[d] += a * bf2f(vp[d]); }
    }
    bf16* op = MIX + (size_t)(b * SEQ + t) * D + 512 + h * HD;
#pragma unroll
    for (int d = 0; d < HD; d += 2) *(unsigned*)(op + d) = f2bf(o[d]) | (f2bf(o[d + 1]) << 16);
}
__global__ __launch_bounds__(256) void k_ffnact(const bf16* __restrict__ RAW, const float* __restrict__ dw_w, const float* __restrict__ dw_b, bf16* __restrict__ H) {
    const int mm = blockIdx.x, tloc = mm % SEQ;
    for (int c = threadIdx.x; c < DFF; c += 256) { const int pn = c >> 7, j = c & 127; const size_t col = 256 * pn + j;
        const float val = bf2f(RAW[(size_t)mm * DUP + col]); const float g0 = bf2f(RAW[(size_t)mm * DUP + col + 128]);
        const float g1 = tloc >= 1 ? bf2f(RAW[(size_t)(mm - 1) * DUP + col + 128]) : 0.f, g2 = tloc >= 2 ? bf2f(RAW[(size_t)(mm - 2) * DUP + col + 128]) : 0.f;
        const float gc = dw_w[c] * g2 + dw_w[DFF + c] * g1 + dw_w[2 * DFF + c] * g0 + dw_b[c];
        const float ge = 0.5f * gc * (1.0f + erff(gc * 0.70710678118654752f));
        H[(size_t)mm * DFF + c] = (bf16)f2bf(val * ge); }
}

extern "C" void kernel_launch(void* const* d_in, const int* in_sizes, int n_in, void* d_out, int out_size, void* d_ws, size_t ws_size, hipStream_t stream) {
    if (n_in != 18 || ws_size < WS_END) { fprintf(stderr, "kernel_launch: unexpected n_in %d / ws %zu\n", n_in, ws_size); return; }
    const float* x = (const float*)d_in[0]; const float* norm1_g = (const float*)d_in[1]; const float* w_in = (const float*)d_in[2];
    const float* cdw_w = (const float*)d_in[3]; const float* cdw_b = (const float*)d_in[4]; const float* cln_g = (const float*)d_in[5]; const float* cln_b = (const float*)d_in[6];
    const float* cpw_w = (const float*)d_in[7]; const float* cpw_b = (const float*)d_in[8]; const float* pool_w = (const float*)d_in[9]; const float* pool_scale = (const float*)d_in[10];
    const float* w_out = (const float*)d_in[11]; const float* norm2_g = (const float*)d_in[12]; const float* ffn_up = (const float*)d_in[13]; const float* fdw_w = (const float*)d_in[14];
    const float* fdw_b = (const float*)d_in[15]; const float* ffn_down = (const float*)d_in[16]; const float* final_g = (const float*)d_in[17];
    unsigned char* ws = (unsigned char*)d_ws; float* out = (float*)d_out;
    float* SS = (float*)(ws + WS_SMALL); float* BO = SS + M;
    bf16* WIN = (bf16*)(ws + WS_WIN); bf16* WOUT = (bf16*)(ws + WS_WOUT); bf16* WUP = (bf16*)(ws + WS_WUP); bf16* WDN = (bf16*)(ws + WS_WDN);
    bf16* XB = (bf16*)(ws + WS_XB); bf16* PROJ = (bf16*)(ws + WS_PROJ); bf16* U = (bf16*)(ws + WS_U); bf16* MIX = (bf16*)(ws + WS_MIX); bf16* H = (bf16*)(ws + WS_H); bf16* RAW = (bf16*)(ws + WS_RAW);
    static bool attr = false; if (!attr) { (void)hipFuncSetAttribute((const void*)k_convpool, hipFuncAttributeMaxDynamicSharedMemorySize, CP_LDS); attr = true; }

    k_wconv<1><<<dim3(DIN / 64, D / 64, DEPTH), 256, 0, stream>>>(w_in, D, DIN, DIN, norm1_g, WIN);
    k_wconv<2><<<dim3(DUP / 64, D / 64, DEPTH), 256, 0, stream>>>(ffn_up, D, DUP, DUP, norm2_g, WUP);
    k_wconv<0><<<dim3(D / 64, DFF / 64, DEPTH), 256, 0, stream>>>(ffn_down, DFF, D, D, nullptr, WDN);
    k_wout<<<dim3(D / 64, D / 16, DEPTH), 256, 0, stream>>>(w_out, cpw_w, pool_w, pool_scale, WOUT);
    k_biasout<<<dim3(D / 256, DEPTH), 256, 0, stream>>>(w_out, cpw_b, BO);
    k_xprep<<<M / 4, 256, 0, stream>>>(x, XB, SS);
    for (int l = 0; l < DEPTH; ++l) {
        const float* xin = (l == 0) ? x : out;
        k_gemm<EpiRowScaleBf16><<<dim3(DIN / 128, M / 128), 256, 0, stream>>>(XB, WIN + (size_t)l * DIN * D, D, EpiRowScaleBf16{PROJ, DIN, SS});
        k_glu<<<M, 256, 0, stream>>>(PROJ, U);
        k_convpool<<<M / 64, 512, CP_LDS, stream>>>(U, PROJ, cdw_w + (size_t)l * CONVK * DCONV, cdw_b + l * DCONV, cln_g + l * DCONV, cln_b + l * DCONV, MIX);
        k_attn<<<dim3(SEQ / 64, NH, BATCH), 64, 0, stream>>>(PROJ, MIX);
        k_gemm<EpiResid><<<dim3(D / 128, M / 128), 256, 0, stream>>>(MIX, WOUT + (size_t)l * D * D, D, EpiResid{xin, out, XB, BO + l * D});
        k_rowss<<<M / 4, 256, 0, stream>>>(out, SS);
        for (int ch = 0; ch < 4; ++ch) {
            k_gemm<EpiRowScaleBf16><<<dim3(DUP / 128, 4096 / 128), 256, 0, stream>>>(XB + (size_t)ch * 4096 * D, WUP + (size_t)l * DUP * D, D, EpiRowScaleBf16{RAW, DUP, SS + ch * 4096});
            k_ffnact<<<4096, 256, 0, stream>>>(RAW, fdw_w + (size_t)l * 3 * DFF, fdw_b + (size_t)l * DFF, H + (size_t)ch * 4096 * DFF);
        }
        k_gemm<EpiResid><<<dim3(D / 128, M / 128), 256, 0, stream>>>(H, WDN + (size_t)l * D * DFF, DFF, EpiResid{out, out, XB, nullptr});
        k_rowss<<<M / 4, 256, 0, stream>>>(out, SS);
    }
    k_final<<<M / 4, 256, 0, stream>>>(out, final_g);
}
```

```cpp
#include <hip/hip_runtime.h>
#include <cstdio>
#include <cstdint>
constexpr int D = 1024, BATCH = 8, SEQ = 2048, DEPTH = 2, M = BATCH * SEQ;
constexpr int DCONV = 256, DPOOL = 256, DATT = 512, NH = 8, HD = 64, CONVK = 31, DFF = 2816, DIN = 2304, DUP = 2 * DFF;
constexpr float EPS = 1e-6f;
namespace pg8 {
#define PG8_LAS __attribute__((address_space(3)))
typedef unsigned short bf16_t;
typedef short bf16x8 __attribute__((ext_vector_type(8)));
typedef float f32x4 __attribute__((ext_vector_type(4)));
typedef unsigned u32x4 __attribute__((ext_vector_type(4)));
constexpr int BM = 256, BK = 64, HALF = 128, HTB = HALF * BK * 2  , STAGE_BYTES = 8 * HTB, NXCD = 8, WGM = 8;

__host__ __device__ __forceinline__ int lds_byte(int r, int c) { const int st = (r >> 4) * 2 + (c >> 5), rr = r & 15, cc = c & 31, ob = rr * 64 + cc * 2; return st * 1024 + (ob ^ (((ob >> 9) & 1) << 5)); }
__host__ __device__ __forceinline__ void stage_rc(int b, int& R, int& C) { const int st = b / 1024, sb = b % 1024, swz = sb ^ (((sb >> 9) & 1) << 5); R = (st >> 1) * 16 + swz / 64; C = (st & 1) * 32 + (swz % 64) / 2; }
__host__ __device__ __forceinline__ int perm32(int rho) { const int n = rho >> 4, i = rho & 15; return 8 * (i >> 2) + 4 * n + (i & 3); }

struct Unit { int pm, pn; };
struct Gemm { const bf16_t* A; const bf16_t* Bt; int M, N, K; };

struct StaticOrder {
    int nM, nN, nwg, G, c;
    __host__ __device__ void init(int M, int N, int G_, int c_) { nM = M / BM; nN = N / BM; nwg = nM * nN; G = G_; c = c_; }
    __host__ __device__ bool next(int i, Unit& u) const {
        const long L = (long)i * G + c; if (L >= nwg) return false;
        int wgid = (int)L; { const int q = nwg / NXCD, r = nwg % NXCD, xcd = wgid % NXCD, off = wgid / NXCD; wgid = (xcd < r ? xcd * (q + 1) : r * (q + 1) + (xcd - r) * q) + off; }
        const int nig = WGM * nN, gid = wgid / nig, fm = gid * WGM, gsz = (nM - fm) < WGM ? (nM - fm) : WGM;
        u.pm = fm + ((wgid % nig) % gsz); u.pn = (wgid % nig) / gsz; return true;
    }
    __device__ __forceinline__ void a_ready(const Unit&) const {}
    __device__ __forceinline__ void done(const Unit&) const {}
};

__device__ __forceinline__ unsigned cvt_pk_bf16(float lo, float hi) { unsigned r; asm volatile("v_cvt_pk_bf16_f32 %0, %1, %2" : "=v"(r) : "v"(lo), "v"(hi)); return r; }
typedef float f32x2 __attribute__((ext_vector_type(2)));
__device__ __forceinline__ f32x2 gelu_pk(f32x2 v) {
    const f32x2 av = __builtin_elementwise_abs(v), d = av * 0.2316418882f + 1.0f;
    f32x2 t; t.x = __builtin_amdgcn_rcpf(d.x); t.y = __builtin_amdgcn_rcpf(d.y);
    f32x2 q = t * 0.5307027145f + (-0.7265760135f); q = q * t + 0.7107068705f; q = q * t + (-0.142248368f); q = q * t + 0.127414796f; q = q * t;
    const f32x2 s = (v * v) * (-0.72134752044f);
    f32x2 e; e.x = __builtin_amdgcn_exp2f(s.x); e.y = __builtin_amdgcn_exp2f(s.y);
    const f32x2 m = v * (q * e), r = v - m;
    f32x2 o; o.x = v.x < 0.f ? m.x : r.x; o.y = v.y < 0.f ? m.y : r.y; return o;
}
template <int X> __device__ __forceinline__ float swz_xor(float v) { return __builtin_bit_cast(float, __builtin_amdgcn_ds_swizzle(__builtin_bit_cast(int, v), (X << 10) | 0x1f)); }
__device__ __forceinline__ float add_xor32(float v) { float a = v, b = v; asm volatile("s_nop 1\n\tv_permlane32_swap_b32 %0, %1" : "+v"(a), "+v"(b)); return a + b; }
__device__ __forceinline__ float wave_sum_all(float v) { v += swz_xor<1>(v); v += swz_xor<2>(v); v += swz_xor<4>(v); v += swz_xor<8>(v); v += swz_xor<16>(v); return add_xor32(v); }
__device__ __forceinline__ float rs_from_ssp(const float* ssp, int R) { const f32x4 s = *(const f32x4*)(ssp + (size_t)R * 4); return 1.0f / sqrtf(((s[0] + s[1]) + (s[2] + s[3])) * (1.0f / 1024.0f) + 1e-6f); }
template <int CTRL> __device__ __forceinline__ float dppf(float old, float src) { return __builtin_bit_cast(float, __builtin_amdgcn_update_dpp(__builtin_bit_cast(int, old), __builtin_bit_cast(int, src), CTRL, 0xf, 0xf, false)); }
constexpr int DPP_SHR1 = 0x111, DPP_SHR2 = 0x112, DPP_ROR1 = 0x121, DPP_ROR2 = 0x122;

struct EpiProj {
    static constexpr bool PERM = true, AFTER_DRAIN = false;
    bf16_t* O; int ldc; const float* ssp;
    __device__ __forceinline__ void operator()(const f32x4 (&acc)[2][2][4][2], const Unit& u, int wr, int wc, int fr, int fq) const {
        const int row0 = u.pm * BM + wr * 64 + fr, col0 = u.pn * BM + wc * 32 + 8 * fq;
#pragma unroll
        for (int ai = 0; ai < 2; ++ai)
#pragma unroll
            for (int m = 0; m < 4; ++m) { const int R = row0 + ai * HALF + m * 16; const float sc = rs_from_ssp(ssp, R); bf16_t* rowp = O + (size_t)R * ldc + col0;
#pragma unroll
                for (int bj = 0; bj < 2; ++bj) { const f32x4 v0 = acc[ai][bj][m][0] * sc, v1 = acc[ai][bj][m][1] * sc;
                    u32x4 w; w.x = cvt_pk_bf16(v0[0], v0[1]); w.y = cvt_pk_bf16(v0[2], v0[3]); w.z = cvt_pk_bf16(v1[0], v1[1]); w.w = cvt_pk_bf16(v1[2], v1[3]);
                    *(u32x4*)(rowp + bj * HALF) = w; } }
    }
};
struct EpiUp {
    static constexpr bool PERM = true, AFTER_DRAIN = false;
    bf16_t* H; const float* ssp; const float* dww; const float* dwb; PG8_LAS float* xl;
    __device__ __forceinline__ void operator()(f32x4 (&acc)[2][2][4][2], const Unit& u, int wr, int wc, int fr, int fq) const {
        const bool halo = (u.pm == 64);
        const int ch0 = u.pn * HALF + wc * 32 + 8 * fq;
#pragma unroll
        for (int ai = 0; ai < 2; ++ai)
#pragma unroll
            for (int m = 0; m < 4; ++m) { const int rt = ai * HALF + wr * 64 + m * 16 + fr; int R = halo ? 256 * (rt >> 2) - 2 + (rt & 3) : u.pm * BM + rt; R = R < 0 ? 0 : R;
                const float sc = rs_from_ssp(ssp, R);
#pragma unroll
                for (int bj = 0; bj < 2; ++bj)
#pragma unroll
                    for (int n = 0; n < 2; ++n) acc[ai][bj][m][n] *= sc; }
        if (fr >= 14) {
#pragma unroll
            for (int ai = 0; ai < 2; ++ai)
#pragma unroll
                for (int n = 0; n < 2; ++n) *(PG8_LAS f32x4*)(xl + ((ai * 2 + wr) * 4 + wc) * 64 + (fr - 14) * 32 + fq * 8 + n * 4) = acc[ai][1][3][n]; }
        asm volatile("s_waitcnt lgkmcnt(0)" ::: "memory"); __builtin_amdgcn_s_barrier(); asm volatile("" ::: "memory");
        f32x4 w0[2], w1[2], w2[2], bb[2];
#pragma unroll
        for (int n = 0; n < 2; ++n) { w0[n] = *(const f32x4*)(dww + ch0 + 4 * n); w1[n] = *(const f32x4*)(dww + DFF + ch0 + 4 * n); w2[n] = *(const f32x4*)(dww + 2 * DFF + ch0 + 4 * n); bb[n] = *(const f32x4*)(dwb + ch0 + 4 * n); }
#pragma unroll
        for (int ai = 0; ai < 2; ++ai)
#pragma unroll
            for (int m = 0; m < 4; ++m) {
                f32x4 prev[2];
                if (m > 0) { prev[0] = acc[ai][1][m - 1][0]; prev[1] = acc[ai][1][m - 1][1]; }
                else { prev[0] = (f32x4){0.f, 0.f, 0.f, 0.f}; prev[1] = prev[0];
                    const int sai = wr ? ai : ai - 1, swr = wr ? 0 : 1;
                    if (!halo && sai >= 0 && fr >= 14) {
#pragma unroll
                        for (int n = 0; n < 2; ++n) prev[n] = *(const PG8_LAS f32x4*)(xl + ((sai * 2 + swr) * 4 + wc) * 64 + (fr - 14) * 32 + fq * 8 + n * 4); } }
                f32x4 hv[2];
#pragma unroll
                for (int n = 0; n < 2; ++n) { const f32x4 cur = acc[ai][1][m][n]; f32x4 g1, g2;
#pragma unroll
                    for (int i = 0; i < 4; ++i) { const float p1 = halo ? 0.f : dppf<DPP_ROR1>(0.f, prev[n][i]), p2 = halo ? 0.f : dppf<DPP_ROR2>(0.f, prev[n][i]);
                        g1[i] = dppf<DPP_SHR1>(p1, cur[i]); g2[i] = dppf<DPP_SHR2>(p2, cur[i]); }
                    const f32x4 gc = w0[n] * g2 + w1[n] * g1 + w2[n] * cur + bb[n];
                    const f32x2 ga = gelu_pk((f32x2){gc[0], gc[1]}), gb = gelu_pk((f32x2){gc[2], gc[3]});
                    hv[n] = acc[ai][0][m][n] * (f32x4){ga.x, ga.y, gb.x, gb.y}; }
                const int rt = ai * HALF + wr * 64 + m * 16 + fr;
                u32x4 w; w.x = cvt_pk_bf16(hv[0][0], hv[0][1]); w.y = cvt_pk_bf16(hv[0][2], hv[0][3]); w.z = cvt_pk_bf16(hv[1][0], hv[1][1]); w.w = cvt_pk_bf16(hv[1][2], hv[1][3]);
                if (!halo) { if (!(rt < 2 && (u.pm & 7) != 0)) *(u32x4*)(H + (size_t)(u.pm * BM + rt) * DFF + ch0) = w; }
                else { const int k = rt >> 2, j = rt & 3; if (j >= 2 && (k & 7) != 0) *(u32x4*)(H + (size_t)(256 * k + j - 2) * DFF + ch0) = w; }
            }
    }
};
struct EpiRes {
    static constexpr bool PERM = false, AFTER_DRAIN = true;
    const float* xin; float* xout; bf16_t* XB; const float* bias; float* sspo;
    __device__ __forceinline__ void fused(f32x4 (&acc)[2][2][4][2], const Unit& u, int wr, int wc, int fr, int fq, PG8_LAS unsigned char* lds, int wid, int lane) const {
        typedef unsigned u32x2v __attribute__((ext_vector_type(2)));
        PG8_LAS float* P = (PG8_LAS float*)lds;
        const int col0 = u.pn * BM + wc * 32 + 4 * fq;
#pragma unroll
        for (int ai = 0; ai < 2; ++ai)
#pragma unroll
            for (int m = 0; m < 4; ++m) { const int rt = ai * HALF + wr * 64 + m * 16 + fr, R = u.pm * BM + rt; const size_t off = (size_t)R * 1024 + col0; float s = 0.f;
                int hr = -1; if (rt < 2) hr = 16384 + 4 * u.pm + 2 + rt; else if (rt >= 254) hr = 16384 + 4 * (u.pm + 1) + (rt - 254);
#pragma unroll
                for (int bj = 0; bj < 2; ++bj)
#pragma unroll
                    for (int n = 0; n < 2; ++n) { const int cc = bj * HALF + n * 16; f32x4 x = *(const f32x4*)(xin + off + cc) + acc[ai][bj][m][n]; if (bias) x += *(const f32x4*)(bias + col0 + cc);
                        *(f32x4*)(xout + off + cc) = x; s += (x[0] * x[0] + x[1] * x[1]) + (x[2] * x[2] + x[3] * x[3]);
                        u32x2v w; w.x = cvt_pk_bf16(x[0], x[1]); w.y = cvt_pk_bf16(x[2], x[3]); *(u32x2v*)(XB + off + cc) = w;
                        if (hr >= 0 && hr < 16384 + 256) *(u32x2v*)(XB + (size_t)hr * 1024 + col0 + cc) = w; }
                s += swz_xor<16>(s); s = add_xor32(s);
                if (fq == 0) P[rt * 4 + wc] = s;
                if (m & 1) asm volatile("" ::: "memory"); }
        asm volatile("s_waitcnt lgkmcnt(0)" ::: "memory"); __builtin_amdgcn_s_barrier(); asm volatile("" ::: "memory");
        const int tid = wid * 64 + lane;
        if (tid < 256) { const f32x4 p = *(const PG8_LAS f32x4*)(P + tid * 4); sspo[(size_t)(u.pm * BM + tid) * 4 + u.pn] = (p[0] + p[1]) + (p[2] + p[3]); }
        asm volatile("s_waitcnt lgkmcnt(0)" ::: "memory"); __builtin_amdgcn_s_barrier(); asm volatile("" ::: "memory");
    }
};
template <class Epi, class Sched, bool ALIGN_EPI = false, bool SP2 = false>
__device__ __forceinline__ void gemm_phase(PG8_LAS unsigned char* lds, const Gemm g, const Sched& S, const Epi& E, int wave_id  ) {
    int tid_; asm volatile("v_mbcnt_lo_u32_b32 %0, -1, 0\n\tv_mbcnt_hi_u32_b32 %0, -1, %0" : "=v"(tid_)); tid_ += 64 * wave_id;
    const int tid = tid_, wid = __builtin_amdgcn_readfirstlane(tid >> 6), lane = tid & 63, wr = wid >> 2, wc = wid & 3, fr = lane & 15, fq = lane >> 4;
    const int K = g.K, nt = K / BK;
    unsigned voffA[2], voffB[2];
#pragma unroll
    for (int i = 0; i < 2; ++i) { int R, C; stage_rc(tid * 16 + i * 8192, R, C); const int Rb = Epi::PERM ? ((R & ~31) + perm32(R & 31)) : R;
        voffA[i] = (unsigned)(R * K + C) * 2u; voffB[i] = (unsigned)(Rb * K + C) * 2u; }
    const size_t kstep = (size_t)(BK * 2);
    const size_t hstep = (size_t)HALF * K * 2;
    const size_t tstep = 2 * hstep;
    const unsigned ldsw = (unsigned)wid * 1024u;
    const int aoff = lds_byte(wr * 64 + fr, fq * 8), boff = lds_byte(wc * 32 + fr, fq * 8);
#define PG8_SA(b, h) (((b) * 2 + (h)) * HTB)
#define PG8_SB(b, h) ((4 + (b) * 2 + (h)) * HTB)
#define PG8_STAGE(bufoff, gbase, voff) do { _Pragma("unroll") for (int _i = 0; _i < 2; ++_i) \
        __builtin_amdgcn_global_load_lds((const unsigned*)((const char*)(gbase) + (voff)[_i]), (PG8_LAS unsigned*)(lds + (bufoff) + ldsw + _i * 8192), 16, 0, 0); } while (0)
#define PG8_LDA(dst, b, h) do { _Pragma("unroll") for (int m = 0; m < 4; ++m) _Pragma("unroll") for (int k = 0; k < 2; ++k) dst[m][k] = *(const PG8_LAS bf16x8*)(lds + PG8_SA(b, h) + aoff + m * 2048 + k * 1024); } while (0)
#define PG8_LDB(dst, b, h) do { _Pragma("unroll") for (int n = 0; n < 2; ++n) _Pragma("unroll") for (int k = 0; k < 2; ++k) dst[n][k] = *(const PG8_LAS bf16x8*)(lds + PG8_SB(b, h) + boff + n * 2048 + k * 1024); } while (0)
#define PG8_MMA(ai, bj, At, Bt) do { __builtin_amdgcn_s_setprio(1); _Pragma("unroll") for (int m = 0; m < 4; ++m) _Pragma("unroll") for (int n = 0; n < 2; ++n) _Pragma("unroll") for (int k = 0; k < 2; ++k) \
        acc[ai][bj][m][n] = __builtin_amdgcn_mfma_f32_16x16x32_bf16(Bt[n][k], At[m][k], acc[ai][bj][m][n], 0, 0, 0); __builtin_amdgcn_s_setprio(0); } while (0)
#define PG8_WAIT_V(n) asm volatile("s_waitcnt vmcnt(" #n ")" ::: "memory")
#define PG8_WAIT_L(n) asm volatile("s_waitcnt lgkmcnt(" #n ")" ::: "memory")
#define PG8_BAR __builtin_amdgcn_s_barrier()
#define PG8_SCHED __builtin_amdgcn_sched_barrier(0)
    Unit cur, nxt; int ui = 0;
    if (!S.next(0, cur)) return;
    f32x4 acc[2][2][4][2];
#pragma unroll
    for (int a = 0; a < 2; ++a)
#pragma unroll
        for (int b = 0; b < 2; ++b)
#pragma unroll
            for (int m = 0; m < 4; ++m)
#pragma unroll
                for (int n = 0; n < 2; ++n) acc[a][b][m][n] = (f32x4){0.f, 0.f, 0.f, 0.f};
    bf16x8 At[4][2], B0[2][2], B1[2][2];
    const char* cA = (const char*)g.A + (size_t)cur.pm * tstep; const char* cB = (const char*)g.Bt + (size_t)cur.pn * tstep;
    S.a_ready(cur);
    if constexpr (SP2) {
        PG8_STAGE(PG8_SB(0, 0), cB, voffB); PG8_STAGE(PG8_SB(0, 1), cB + hstep, voffB); PG8_STAGE(PG8_SA(0, 0), cA, voffA); PG8_STAGE(PG8_SA(0, 1), cA + hstep, voffA);
        if (wr == 1) PG8_BAR;
        PG8_WAIT_V(2); PG8_BAR;
        PG8_STAGE(PG8_SB(1, 0), cB + kstep, voffB); PG8_STAGE(PG8_SA(1, 0), cA + kstep, voffA); PG8_STAGE(PG8_SB(1, 1), cB + hstep + kstep, voffB);
        PG8_WAIT_V(6); PG8_BAR;
    } else {
        PG8_STAGE(PG8_SB(0, 0), cB, voffB); PG8_STAGE(PG8_SA(0, 0), cA, voffA); PG8_STAGE(PG8_SB(0, 1), cB + hstep, voffB); PG8_STAGE(PG8_SA(0, 1), cA + hstep, voffA);
        if (wr == 1) PG8_BAR;
        PG8_WAIT_V(4); PG8_BAR;
        PG8_STAGE(PG8_SB(1, 0), cB + kstep, voffB); PG8_STAGE(PG8_SA(1, 0), cA + kstep, voffA); PG8_STAGE(PG8_SB(1, 1), cB + hstep + kstep, voffB);
        PG8_WAIT_V(6); PG8_BAR;
    }
    for (;;) {
        const bool has_next = S.next(ui + 1, nxt);
        const char* nA = has_next ? (const char*)g.A + (size_t)nxt.pm * tstep : cA; const char* nB = has_next ? (const char*)g.Bt + (size_t)nxt.pn * tstep : cB;
        for (int t = 0; t < nt; t += 2) {
            const bool last = (t == nt - 2);
            const char* a1 = cA + (size_t)(t + 1) * kstep;
            const char* a2 = last ? nA : cA + (size_t)(t + 2) * kstep; const char* b2 = last ? nB : cB + (size_t)(t + 2) * kstep;
            const char* a3 = a2 + kstep; const char* b3 = b2 + kstep;
            if (last && has_next) S.a_ready(nxt);
            if constexpr (SP2) {
            PG8_LDB(B0, 0, 0); PG8_LDB(B1, 0, 1); PG8_SCHED; PG8_LDA(At, 0, 0); PG8_STAGE(PG8_SA(1, 1), a1 + hstep, voffA);
            PG8_WAIT_V(8); PG8_WAIT_L(0); PG8_BAR; PG8_MMA(0, 0, At, B0); PG8_MMA(0, 1, At, B1); PG8_BAR; PG8_SCHED;
            PG8_LDA(At, 0, 1); PG8_STAGE(PG8_SB(0, 0), b2, voffB); PG8_STAGE(PG8_SB(0, 1), b2 + hstep, voffB); PG8_STAGE(PG8_SA(0, 0), a2, voffA);
            PG8_WAIT_V(8); PG8_WAIT_L(0); PG8_BAR; PG8_MMA(1, 0, At, B0); PG8_MMA(1, 1, At, B1); PG8_BAR; PG8_SCHED;
            PG8_LDB(B0, 1, 0); PG8_LDB(B1, 1, 1); PG8_SCHED; PG8_LDA(At, 1, 0); PG8_STAGE(PG8_SA(0, 1), a2 + hstep, voffA);
            PG8_WAIT_V(8); PG8_WAIT_L(0); PG8_BAR; PG8_MMA(0, 0, At, B0); PG8_MMA(0, 1, At, B1); PG8_BAR; PG8_SCHED;
            PG8_LDA(At, 1, 1); PG8_STAGE(PG8_SB(1, 0), b3, voffB); PG8_STAGE(PG8_SB(1, 1), b3 + hstep, voffB); PG8_STAGE(PG8_SA(1, 0), a3, voffA);
            PG8_WAIT_V(8); PG8_WAIT_L(0); PG8_BAR; PG8_MMA(1, 0, At, B0); PG8_MMA(1, 1, At, B1); PG8_BAR; PG8_SCHED;
            } else {
            PG8_LDB(B0, 0, 0); PG8_SCHED; PG8_LDA(At, 0, 0); PG8_STAGE(PG8_SA(1, 1), a1 + hstep, voffA);
            PG8_WAIT_L(8); PG8_BAR; PG8_WAIT_L(0); PG8_MMA(0, 0, At, B0); PG8_BAR; PG8_SCHED;
            PG8_LDB(B1, 0, 1); PG8_STAGE(PG8_SB(0, 0), b2, voffB);
            PG8_BAR; PG8_WAIT_L(0); PG8_MMA(0, 1, At, B1); PG8_BAR;
            PG8_LDA(At, 0, 1); PG8_STAGE(PG8_SA(0, 0), a2, voffA);
            PG8_BAR; PG8_WAIT_L(0); PG8_MMA(1, 0, At, B0); PG8_BAR; PG8_SCHED;
            PG8_STAGE(PG8_SB(0, 1), b2 + hstep, voffB);
            PG8_WAIT_V(6); PG8_BAR; PG8_MMA(1, 1, At, B1); PG8_BAR;
            PG8_LDB(B0, 1, 0); PG8_SCHED; PG8_LDA(At, 1, 0); PG8_STAGE(PG8_SA(0, 1), a2 + hstep, voffA);
            PG8_WAIT_L(8); PG8_BAR; PG8_WAIT_L(0); PG8_MMA(0, 0, At, B0); PG8_BAR; PG8_SCHED;
            PG8_LDB(B1, 1, 1); PG8_STAGE(PG8_SB(1, 0), b3, voffB);
            PG8_BAR; PG8_WAIT_L(0); PG8_MMA(0, 1, At, B1); PG8_BAR;
            PG8_LDA(At, 1, 1); PG8_STAGE(PG8_SA(1, 0), a3, voffA);
            PG8_BAR; PG8_WAIT_L(0); PG8_MMA(1, 0, At, B0); PG8_BAR; PG8_SCHED;
            PG8_STAGE(PG8_SB(1, 1), b3 + hstep, voffB);
            PG8_WAIT_V(6); PG8_BAR; PG8_MMA(1, 1, At, B1); PG8_BAR;
            }
        }
        if constexpr (ALIGN_EPI) { if (wr == 0) PG8_BAR; }
        if constexpr (!Epi::AFTER_DRAIN) { E(acc, cur, wr, wc, fr, fq); S.done(cur); }
        if (!has_next) break;
#pragma unroll
        for (int a = 0; a < 2; ++a)
#pragma unroll
            for (int b = 0; b < 2; ++b)
#pragma unroll
                for (int m = 0; m < 4; ++m)
#pragma unroll
                    for (int n = 0; n < 2; ++n) acc[a][b][m][n] = (f32x4){0.f, 0.f, 0.f, 0.f};
        cur = nxt; cA = nA; cB = nB; ++ui;
        if constexpr (ALIGN_EPI) { if (wr == 1) PG8_BAR; }
    }
    PG8_WAIT_V(0);
    if constexpr (!ALIGN_EPI) { if (wr == 0) PG8_BAR; }
    PG8_BAR;
    if constexpr (Epi::AFTER_DRAIN) { E.fused(acc, cur, wr, wc, fr, fq, lds, wid, lane); S.done(cur); }
#undef PG8_SA
#undef PG8_SB
#undef PG8_STAGE
#undef PG8_LDA
#undef PG8_LDB
#undef PG8_MMA
#undef PG8_WAIT_V
#undef PG8_WAIT_L
#undef PG8_BAR
#undef PG8_SCHED
}
}

#ifndef PG8_SP2
#define PG8_SP2 true
#endif
#ifndef PG8_ALIGN
#define PG8_ALIGN true
#endif
#define GAS __attribute__((address_space(1)))
#define LAS __attribute__((address_space(3)))
typedef unsigned short bf16;
typedef unsigned v4u __attribute__((ext_vector_type(4)));
typedef float f32x4 __attribute__((ext_vector_type(4)));
typedef short bf16x8 __attribute__((ext_vector_type(8)));
typedef GAS unsigned gu32;
typedef GAS unsigned long long gu64;
#define RLX_AGENT __ATOMIC_RELAXED, __HIP_MEMORY_SCOPE_AGENT
#define LDS_WAIT() asm volatile("s_waitcnt lgkmcnt(0)" ::: "memory")
#define VM_WAIT() asm volatile("s_waitcnt vmcnt(0)" ::: "memory")
__device__ __forceinline__ unsigned long long rt() { return __builtin_amdgcn_s_memrealtime(); }
__device__ __forceinline__ unsigned f2bf(float f) { unsigned u = __builtin_bit_cast(unsigned, f); return (u + 0x7fffu + ((u >> 16) & 1u)) >> 16; }
__device__ __forceinline__ unsigned pk2(float lo, float hi) { return f2bf(lo) | (f2bf(hi) << 16); }

#define XB_TMO      128
#define XB_XCNT(j)  (256  + 64 * (j))
#define XB_XSUB(j)  (1280 + 64 * (j))
#define XB_XGEN(j)  (2304 + 64 * (j))
#define XB_TOP      3328
#define XB_TOPGEN   3392
#define XCD_BAR_WORDS 3456
#define XB_SPIN_CAP (1u << 18)

__device__ __forceinline__ unsigned xb_ld(unsigned* p)              { return __hip_atomic_load(p, __ATOMIC_RELAXED, __HIP_MEMORY_SCOPE_AGENT); }
__device__ __forceinline__ unsigned xb_add(unsigned* p, unsigned v) { return __hip_atomic_fetch_add(p, v, __ATOMIC_RELAXED, __HIP_MEMORY_SCOPE_AGENT); }
__device__ __forceinline__ unsigned xb_xcc_id() { return (unsigned)__builtin_amdgcn_s_getreg((3 << 11) | 20) & 0xFu; }
#define XB_SPIN(cond, bar) do { unsigned _sp = 0; while (cond) { __builtin_amdgcn_s_sleep(1); \
    if ((++_sp & 255u) == 0u) { if (xb_ld(&(bar)[XB_TMO])) break; if (_sp > XB_SPIN_CAP) { atomicAdd(&(bar)[XB_TMO], 1u); break; } } } } while (0)

struct XcdBarrier {
    unsigned* bar; unsigned x;
    volatile LAS unsigned* st;
};

__device__ __forceinline__ XcdBarrier xcd_barrier_post(unsigned* bar, volatile LAS unsigned* st) {
    XcdBarrier b; b.bar = bar; b.x = xb_xcc_id(); b.st = st;
    if (threadIdx.x == 0) (void)xb_add(&bar[XB_XCNT(b.x)], 1u);
    return b;
}
__device__ __forceinline__ void xcd_barrier_complete(unsigned* bar, unsigned x, unsigned& nloc, unsigned& nx) {
    const unsigned G = gridDim.x * gridDim.y * gridDim.z;
    unsigned sum, cnt, mine, sp = 0u;
    for (;;) {
        sum = 0u; cnt = 0u; mine = 0u;
#pragma unroll
        for (unsigned j = 0; j < 16; ++j) { const unsigned c = xb_ld(&bar[XB_XCNT(j)]); sum += c; cnt += (c > 0u) ? 1u : 0u; }
        mine = xb_ld(&bar[XB_XCNT(x)]);
        if (sum == G) break;
        __builtin_amdgcn_s_sleep(1);
        if ((++sp & 255u) == 0u) { if (xb_ld(&bar[XB_TMO])) break; if (sp > XB_SPIN_CAP) { atomicAdd(&bar[XB_TMO], 1u); break; } }
    }
    nloc = mine > 0u ? mine : 1u; nx = cnt > 0u ? cnt : 1u;
}

__device__ __forceinline__ void xcd_barrier(const XcdBarrier& b) {
    asm volatile("s_waitcnt vmcnt(0)" ::: "memory");
    __syncthreads();
    if (threadIdx.x == 0) {
        unsigned* bar = b.bar;
        __builtin_amdgcn_s_waitcnt(0);
        unsigned nloc = b.st[0], nx = b.st[1];
        if (nloc == 0u) { xcd_barrier_complete(bar, b.x, nloc, nx); b.st[0] = nloc; b.st[1] = nx; }
        const unsigned old = xb_add(&bar[XB_XSUB(b.x)], 1u);
        const unsigned gen = old / nloc;
        if (old + 1u == (gen + 1u) * nloc) {
            __builtin_amdgcn_fence(__ATOMIC_RELEASE, "agent");
            asm volatile("s_waitcnt vmcnt(0)" ::: "memory");
            const unsigned og = xb_add(&bar[XB_TOP], 1u);
            const unsigned tg = og / nx;
            if (og + 1u == (tg + 1u) * nx) xb_add(&bar[XB_TOPGEN], 1u);
            else XB_SPIN(xb_ld(&bar[XB_TOPGEN]) == tg, bar);
            __builtin_amdgcn_fence(__ATOMIC_ACQUIRE, "agent");
            xb_add(&bar[XB_XGEN(b.x)], 1u);
            asm volatile("s_waitcnt vmcnt(0)" ::: "memory");
        } else {
            XB_SPIN(xb_ld(&bar[XB_XGEN(b.x)]) == gen, bar);
            __builtin_amdgcn_fence(__ATOMIC_ACQUIRE, "agent");
            asm volatile("s_waitcnt vmcnt(0)" ::: "memory");
        }
    }
    __syncthreads();
}


constexpr int NWAVES = 8;
#ifndef MK_N_LAUNCHES
#define MK_N_LAUNCHES 12
#endif
constexpr int N_PHASES = 12;
constexpr size_t MiB = 1u << 20;
constexpr size_t WS_CTL = 0, CTL_ZERO_BYTES = 64 * 1024;
constexpr int CW_BAR = 4096;
constexpr size_t WS_SSPA = 1 * MiB, WS_SSPB = WS_SSPA + 256 * 1024, WS_BO = WS_SSPB + 256 * 1024;
constexpr size_t WS_WIN = 2 * MiB, WS_WOUT = 11 * MiB, WS_WUP = 15 * MiB, WS_WDN = 37 * MiB;
constexpr size_t WS_XB = 48 * MiB;
constexpr size_t WS_R = 81 * MiB, WS_PROJ = WS_R, WS_MIX = WS_R + 72 * MiB, WS_H = WS_R, WS_END = WS_R + 104 * MiB;
static_assert(WS_XB + (size_t)(M + 256) * D * 2 <= WS_R && WS_END <= 256 * MiB && WS_H + (size_t)M * DFF * 2 <= WS_END && WS_MIX + (size_t)M * D * 2 <= WS_END, "ws map");
constexpr int RING_OFF = 0, RING_BYTES = 131072, XL_OFF = RING_BYTES, LDSCTL_OFF = XL_OFF + 4096, MISC_OFF = LDSCTL_OFF + 320, LDS_BYTES = 147456;

struct Frame { LAS unsigned char* lds; volatile LAS unsigned* MISC; gu32* ctl; int tid, lane, wave, vcu, G; };
__device__ __forceinline__ float wave_sum(float v) { return pg8::wave_sum_all(v); }
__device__ __forceinline__ float bf2f(unsigned short b) { return __builtin_bit_cast(float, (unsigned)b << 16); }
__device__ __forceinline__ int map_in(int n) { const int t = n >> 8, j = n & 255; return (t < 2) ? ((j < 128) ? 128 * t + j : 256 + 128 * t + (j - 128)) : n; }
__device__ __forceinline__ int map_up(int n) { const int t = n >> 8, j = n & 255; return (j < 128) ? 128 * t + j : DFF + 128 * t + (j - 128); }

__device__ __forceinline__ void p0_transpose_item(const float* W, int K, int N, const float* g, bf16* WT, int src0, int n0, int k0, LAS float* scr, int lane) {
#pragma unroll 8
    for (int i = 0; i < 32; ++i) { const int kk = 2 * i + (lane >> 5); float v = W[(size_t)(k0 + kk) * N + src0 + (lane & 31)]; if (g) v *= g[k0 + kk]; scr[kk * 33 + (lane & 31)] = v; }
    LDS_WAIT(); asm volatile("" ::: "memory");
    const int c = lane & 7;
#pragma unroll
    for (int j = 0; j < 4; ++j) { const int n = (lane >> 3) + 8 * j; const LAS float* s = scr + (8 * c) * 33 + n;
        v4u o; o.x = pk2(s[0 * 33], s[1 * 33]); o.y = pk2(s[2 * 33], s[3 * 33]); o.z = pk2(s[4 * 33], s[5 * 33]); o.w = pk2(s[6 * 33], s[7 * 33]);
        *(v4u*)(WT + (size_t)(n0 + n) * K + k0 + 8 * c) = o; }
    LDS_WAIT(); asm volatile("" ::: "memory");
}
struct Ptrs {
    const float *x, *norm1_g, *w_in, *cdw_w, *cdw_b, *cln_g, *cln_b, *cpw_w, *cpw_b, *pool_w, *pool_scale, *w_out, *norm2_g, *ffn_up, *fdw_w, *fdw_b, *ffn_down, *final_g;
    float* out; float *SSPA, *SSPB, *BO; bf16 *WIN, *WOUT, *WUP, *WDN, *XB, *PROJ, *MIX, *H;
};
__device__ __forceinline__ void p0_prologue(Frame& F, const Ptrs& P) {
    LAS float* scr = (LAS float*)(F.lds + RING_OFF + F.wave * 16384);
    const int gw = F.vcu * NWAVES + F.wave, NGW = F.G * NWAVES, lane = F.lane;
    constexpr int I_IN = 16 * 72, I_UP = 16 * 176, I_DN = 44 * 32, I_L = I_IN + I_UP + I_DN;
    for (int it = gw; it < DEPTH * I_L; it += NGW) {
        const int l = it / I_L; int r = it % I_L;
        if (r < I_IN) { const int kb = r / 72, nb = r % 72; p0_transpose_item(P.w_in + (size_t)l * D * DIN, D, DIN, P.norm1_g + l * D, P.WIN + (size_t)l * DIN * D, map_in(32 * nb), 32 * nb, 64 * kb, scr, lane); continue; } r -= I_IN;
        if (r < I_UP) { const int kb = r / 176, nb = r % 176; p0_transpose_item(P.ffn_up + (size_t)l * D * DUP, D, DUP, P.norm2_g + l * D, P.WUP + (size_t)l * DUP * D, map_up(32 * nb), 32 * nb, 64 * kb, scr, lane); continue; } r -= I_UP;
        { const int kb = r / 32, nb = r % 32; p0_transpose_item(P.ffn_down + (size_t)l * DFF * D, DFF, D, nullptr, P.WDN + (size_t)l * D * DFF, 32 * nb, 32 * nb, 64 * kb, scr, lane); }
    }
    for (int it = gw; it < DEPTH * 128 * 16; it += NGW) {
        const int l = it / 2048, kg = (it % 2048) / 16, nt = it % 16, k0 = 8 * kg, n = 64 * nt + lane;
        const float* wo = P.w_out + (size_t)l * D * D; float acc[8];
#pragma unroll
        for (int i = 0; i < 8; ++i) acc[i] = 0.f;
        if (kg < 32) { const float* pw = P.cpw_w + (size_t)l * DCONV * DCONV + (size_t)k0 * DCONV;
            for (int j = 0; j < 256; ++j) { const float wv = wo[(size_t)j * D + n];
#pragma unroll
                for (int i = 0; i < 8; ++i) acc[i] += pw[i * DCONV + j] * wv; } }
        else if (kg < 64) { const int g = (k0 - 256) >> 6, c0 = (k0 - 256) & 63; const float* pw = P.pool_w + (size_t)l * 4 * 64 * 64 + (size_t)(g * 64 + c0) * 64; const float* ps = P.pool_scale + l * DPOOL + 64 * g;
            for (int d = 0; d < 64; ++d) { const float wv = ps[d] * wo[(size_t)(256 + 64 * g + d) * D + n];
#pragma unroll
                for (int i = 0; i < 8; ++i) acc[i] += pw[i * 64 + d] * wv; } }
        else {
#pragma unroll
            for (int i = 0; i < 8; ++i) acc[i] = wo[(size_t)(k0 + i) * D + n]; }
        v4u o; o.x = pk2(acc[0], acc[1]); o.y = pk2(acc[2], acc[3]); o.z = pk2(acc[4], acc[5]); o.w = pk2(acc[6], acc[7]);
        *(v4u*)(P.WOUT + (size_t)l * D * D + (size_t)n * D + k0) = o;
    }
    for (int it = gw; it < DEPTH * 16; it += NGW) { const int l = it / 16, n = 64 * (it % 16) + lane; float acc = 0.f;
        for (int j = 0; j < 256; ++j) acc += P.cpw_b[l * DCONV + j] * P.w_out[(size_t)l * D * D + (size_t)j * D + n];
        P.BO[l * D + n] = acc; }
    for (int row = gw; row < M; row += NGW) {
        const f32x4* xr = (const f32x4*)(P.x + (size_t)row * D) + lane; float s = 0.f; unsigned long long* o = (unsigned long long*)(P.XB + (size_t)row * D) + lane;
#pragma unroll
        for (int j = 0; j < 4; ++j) { const f32x4 v = xr[64 * j]; s += (v.x * v.x + v.y * v.y) + (v.z * v.z + v.w * v.w); o[64 * j] = (unsigned long long)pk2(v.x, v.y) | ((unsigned long long)pk2(v.z, v.w) << 32); }
        s = wave_sum(s); if (lane == 0) *(f32x4*)(P.SSPB + (size_t)row * 4) = (f32x4){s, 0.f, 0.f, 0.f};
    }
}
__device__ __forceinline__ void convpool_unit(Frame& F, const Ptrs& P, int l, int t0) {
    bf16* Ul = (bf16*)(F.lds + RING_OFF); float* Y = (float*)(F.lds + RING_OFF + 94 * 256 * 2);
    LAS bf16* UlL = (LAS bf16*)(F.lds + RING_OFF); LAS float* YL = (LAS float*)(F.lds + RING_OFF + 94 * 256 * 2); (void)Ul; (void)Y;
    const int tid = F.tid, tl = t0 % SEQ; const bf16* PR = P.PROJ;
    for (int i = tid; i < 94 * 32; i += 512) { const int r = i >> 5, ch = i & 31, c0 = ch * 8, tt = c0 >> 7, j = c0 & 127; const int tok = tl - 30 + r; v4u o = {0u, 0u, 0u, 0u};
        if (tok >= 0) { const bf16* rp = PR + (size_t)(t0 - 30 + r) * DIN + 256 * tt + j; const v4u a = *(const v4u*)rp, g = *(const v4u*)(rp + 128); unsigned ov[4];
#pragma unroll
            for (int q = 0; q < 4; ++q) { const unsigned aw = ((const unsigned*)&a)[q], gw_ = ((const unsigned*)&g)[q];
                const float a0 = bf2f((unsigned short)(aw & 0xffff)), a1 = bf2f((unsigned short)(aw >> 16)), g0 = bf2f((unsigned short)(gw_ & 0xffff)), g1 = bf2f((unsigned short)(gw_ >> 16));
                ov[q] = pk2(a0 / (1.0f + __expf(-g0)), a1 / (1.0f + __expf(-g1))); }
            o.x = ov[0]; o.y = ov[1]; o.z = ov[2]; o.w = ov[3]; }
        *(LAS v4u*)(UlL + r * 256 + c0) = o; }
    __syncthreads();
    const int c = tid & 255, half = tid >> 8;
    { const float* dw_w = P.cdw_w + (size_t)l * CONVK * DCONV; float w[CONVK];
#pragma unroll
      for (int i = 0; i < CONVK; ++i) w[i] = dw_w[i * DCONV + c];
      const float bb = P.cdw_b[l * DCONV + c];
      for (int g = 0; g < 8; ++g) { const int tb = half * 32 + g * 4; float in[34];
#pragma unroll
          for (int i = 0; i < 34; ++i) in[i] = bf2f(UlL[(tb + i) * 256 + c]);
#pragma unroll
          for (int q = 0; q < 4; ++q) { float acc = bb;
#pragma unroll
              for (int i = 0; i < CONVK; ++i) acc += w[i] * in[q + i];
              YL[(tb + q) * 256 + c] = acc; } } }
    __syncthreads();
    { const int wv = F.wave, lane = F.lane; const f32x4 gg = ((const f32x4*)(P.cln_g + l * DCONV))[lane], bbv = ((const f32x4*)(P.cln_b + l * DCONV))[lane];
      for (int q = 0; q < 8; ++q) { const int t = wv * 8 + q; f32x4 y = ((const LAS f32x4*)(YL + t * 256))[lane];
          const float mu = wave_sum((y.x + y.y) + (y.z + y.w)) * (1.0f / 256.0f); y = y - mu;
          const float var = wave_sum((y.x * y.x + y.y * y.y) + (y.z * y.z + y.w * y.w)) * (1.0f / 256.0f); const float rs = 1.0f / sqrtf(var + EPS);
          f32x4 z = y * rs * gg + bbv; z.x = z.x / (1.0f + __expf(-z.x)); z.y = z.y / (1.0f + __expf(-z.y)); z.z = z.z / (1.0f + __expf(-z.z)); z.w = z.w / (1.0f + __expf(-z.w));
          *(unsigned long long*)(P.MIX + (size_t)(t0 + t) * D + 4 * lane) = (unsigned long long)pk2(z.x, z.y) | ((unsigned long long)pk2(z.z, z.w) << 32); } }
    { const int win = 2 << (c >> 6); const bf16* pc = PR + 512 + c; float s = 0.f; const int tb = tl + half * 32;
      for (int j = 1; j < win; ++j) if (tb - j >= 0) s += bf2f(pc[(size_t)(t0 + half * 32 - j) * DIN]);
      for (int q = 0; q < 32; ++q) { const int tloc = tb + q; const size_t row = (size_t)(t0 + half * 32 + q); const float p = bf2f(pc[row * DIN]); s += p;
          const int cnt = (tloc + 1 < win) ? tloc + 1 : win; const float o = s / (float)cnt - p; P.MIX[row * D + 256 + c] = (bf16)f2bf(o);
          if (tloc - win + 1 >= 0) s -= bf2f(pc[(row - (size_t)(win - 1)) * DIN]); } }
    __syncthreads();
}
__device__ __forceinline__ void attn_naive_unit(const Ptrs& P, int b, int h, int qb, int lane) {
    const int t = qb * 64 + lane; const bf16* base = P.PROJ + (size_t)b * SEQ * DIN; float q[HD], o[HD];
    { const bf16* qp = base + (size_t)t * DIN + 768 + h * HD;
#pragma unroll
      for (int d = 0; d < HD; ++d) { q[d] = bf2f(qp[d]) * 0.125f; o[d] = 0.f; } }
    float carry = 0.f;
    for (int s = qb * 64 + 62; s >= 0; --s) {
        const bf16* kp = base + (size_t)s * DIN + 1280 + h * HD; const bf16* vp = base + (size_t)s * DIN + 1792 + h * HD;
        float z = 0.f;
#pragma unroll
        for (int d = 0; d < HD; ++d) z += q[d] * bf2f(kp[d]);
        const float sp = fmaxf(z, 0.f) + log1pf(expf(-fabsf(z)));
        if (s < t) { carry += sp; const float a = expf(z - carry);
#pragma unroll
            for (int d = 0; d < HD; ++d) o[d] += a * bf2f(vp[d]); }
    }
    bf16* op = P.MIX + (size_t)(b * SEQ + t) * D + 512 + h * HD;
#pragma unroll
    for (int d = 0; d < HD; d += 2) *(unsigned*)(op + d) = pk2(o[d], o[d + 1]);
}
__device__ __forceinline__ void mixers_phase(Frame& F, const Ptrs& P, int l) {
    for (int u = F.vcu; u < M / 64; u += F.G) convpool_unit(F, P, l, 64 * u);
    const int gw = F.vcu * NWAVES + F.wave, NGW = F.G * NWAVES;
    for (int uid = gw; uid < 2048; uid += NGW) { const int c = uid >> 3, w = uid & 7, bh = c >> 2, j = c & 3; const int qb = (w & 1) ? (8 * (w >> 1) + 7 - j) : (8 * (w >> 1) + j);
        attn_naive_unit(P, bh >> 3, bh & 7, qb, F.lane); }
}
__device__ __forceinline__ void final_phase(Frame& F, const Ptrs& P) {
    const int gw = F.vcu * NWAVES + F.wave, NGW = F.G * NWAVES, lane = F.lane;
    for (int row = gw; row < M; row += NGW) { f32x4* xr = (f32x4*)(P.out + (size_t)row * D) + lane; const f32x4* gr = (const f32x4*)P.final_g + lane;
        const float r = pg8::rs_from_ssp(P.SSPB, row);
#pragma unroll
        for (int j = 0; j < 4; ++j) xr[64 * j] = xr[64 * j] * r * gr[64 * j]; }
}

#define MKP() Ptrs P; do { unsigned char* ws = args.ws; asm volatile("" : "+s"(ws)); P.x = args.in[0]; P.norm1_g = args.in[1]; P.w_in = args.in[2]; P.cdw_w = args.in[3]; P.cdw_b = args.in[4]; P.cln_g = args.in[5]; P.cln_b = args.in[6]; P.cpw_w = args.in[7]; P.cpw_b = args.in[8]; P.pool_w = args.in[9]; P.pool_scale = args.in[10]; P.w_out = args.in[11]; P.norm2_g = args.in[12]; P.ffn_up = args.in[13]; P.fdw_w = args.in[14]; P.fdw_b = args.in[15]; P.ffn_down = args.in[16]; P.final_g = args.in[17]; P.out = args.out; P.SSPA = (float*)(ws + WS_SSPA); P.SSPB = (float*)(ws + WS_SSPB); P.BO = (float*)(ws + WS_BO); P.WIN = (bf16*)(ws + WS_WIN); P.WOUT = (bf16*)(ws + WS_WOUT); P.WUP = (bf16*)(ws + WS_WUP); P.WDN = (bf16*)(ws + WS_WDN); P.XB = (bf16*)(ws + WS_XB); P.PROJ = (bf16*)(ws + WS_PROJ); P.MIX = (bf16*)(ws + WS_MIX); P.H = (bf16*)(ws + WS_H); } while (0)
struct Args { const float* in[18]; float* out; unsigned char* ws; int ph_lo, ph_hi; };
__global__ void __launch_bounds__(NWAVES * 64, 2) mega_fwd(Args args) {
    extern __shared__ __attribute__((aligned(16))) unsigned char lds[];
    Frame F;
    F.lds = (LAS unsigned char*)lds; F.MISC = (volatile LAS unsigned*)(F.lds + MISC_OFF);
    F.tid = threadIdx.x; F.lane = F.tid & 63; F.wave = __builtin_amdgcn_readfirstlane(F.tid >> 6);
    F.G = gridDim.x; { const int bx = blockIdx.x; F.vcu = (F.G % 8 == 0) ? (bx % 8) * (F.G / 8) + bx / 8 : bx; }
    F.ctl = (gu32*)(args.ws + WS_CTL);
    for (int u = F.tid; u < (LDS_BYTES - LDSCTL_OFF) / 4; u += NWAVES * 64) ((LAS unsigned*)(F.lds + LDSCTL_OFF))[u] = 0u;
    __syncthreads();
    const int lo = args.ph_lo, hi = args.ph_hi;
    const bool use_bar = (hi - lo) > 1;
    XcdBarrier bar; bar.bar = (unsigned*)(F.ctl + CW_BAR); bar.x = 0; bar.st = nullptr;
    if (use_bar) bar = xcd_barrier_post((unsigned*)(F.ctl + CW_BAR), F.MISC + 8);
#define REFRESH() do { int l_; asm volatile("v_mbcnt_lo_u32_b32 %0, -1, 0\n\tv_mbcnt_hi_u32_b32 %0, -1, %0" : "=v"(l_)); F.lane = l_; F.tid = 64 * F.wave + l_; } while (0)
#define LAUNDER_S(v) asm volatile("" : "+s"(v))
#pragma nounroll
    for (int ph_ = lo; ph_ < hi; ++ph_) {
        int ph = ph_; LAUNDER_S(ph);
        const int l = (ph - 1) / 5, st = (ph == 0) ? -1 : (ph == N_PHASES - 1 ? 5 : (ph - 1) % 5);
        int bx = (int)blockIdx.x; LAUNDER_S(bx);
        MKP();
        if (st == -1) { REFRESH(); p0_prologue(F, P); }
        else if (st == 0) {
            pg8::Gemm g{P.XB, P.WIN + (size_t)l * DIN * D, M, DIN, D}; pg8::StaticOrder S; S.init(M, DIN, F.G, bx);
            pg8::EpiProj E{P.PROJ, DIN, P.SSPB};
            pg8::gemm_phase<pg8::EpiProj, pg8::StaticOrder, PG8_ALIGN, PG8_SP2>(F.lds + RING_OFF, g, S, E, F.wave); }
        else if (st == 1) { REFRESH(); mixers_phase(F, P, l); }
        else if (st == 2 || st == 4) {
            const bool o = (st == 2);
            pg8::Gemm g{o ? P.MIX : P.H, o ? P.WOUT + (size_t)l * D * D : P.WDN + (size_t)l * D * DFF, M, D, o ? D : DFF}; pg8::StaticOrder S; S.init(M, D, F.G, bx);
            pg8::EpiRes E{(o && l == 0) ? P.x : P.out, P.out, P.XB, o ? P.BO + l * D : nullptr, o ? P.SSPA : P.SSPB};
            pg8::gemm_phase<pg8::EpiRes, pg8::StaticOrder, false, PG8_SP2>(F.lds + RING_OFF, g, S, E, F.wave); }
        else if (st == 3) {
            pg8::Gemm g{P.XB, P.WUP + (size_t)l * DUP * D, M + 256, DUP, D}; pg8::StaticOrder S; S.init(M + 256, DUP, F.G, bx);
            pg8::EpiUp E{P.H, P.SSPA, P.fdw_w + (size_t)l * 3 * DFF, P.fdw_b + (size_t)l * DFF, (LAS float*)(F.lds + XL_OFF)};
            pg8::gemm_phase<pg8::EpiUp, pg8::StaticOrder, true, PG8_SP2>(F.lds + RING_OFF, g, S, E, F.wave); }
        else { REFRESH(); final_phase(F, P); }
        if (ph_ + 1 < hi) xcd_barrier(bar);
    }
}

extern "C" void kernel_launch(void* const* d_in, const int* in_sizes, int n_in, void* d_out, int out_size, void* d_ws, size_t ws_size, hipStream_t stream) {
    static int grid = 0;
    if (grid == 0) {
        if (n_in != 18 || in_sizes[0] != M * D || out_size != M * D || ws_size < WS_END) { fprintf(stderr, "kernel_launch: unexpected shapes (n_in %d, ws %zu)\n", n_in, ws_size); grid = -1; return; }
        int dev = 0, cus = 0, per_cu = 0;
        if (hipGetDevice(&dev) != hipSuccess || hipDeviceGetAttribute(&cus, hipDeviceAttributeMultiprocessorCount, dev) != hipSuccess) { grid = -1; return; }
        if (hipFuncSetAttribute((const void*)mega_fwd, hipFuncAttributeMaxDynamicSharedMemorySize, LDS_BYTES) != hipSuccess) { fprintf(stderr, "kernel_launch: hipFuncSetAttribute failed\n"); grid = -1; return; }
        if (hipOccupancyMaxActiveBlocksPerMultiprocessor(&per_cu, (const void*)mega_fwd, NWAVES * 64, LDS_BYTES) != hipSuccess || per_cu < 1) { fprintf(stderr, "kernel_launch: occupancy query says %d blocks per CU\n", per_cu); }
        (void)hipGetLastError();
        grid = cus;
        if (grid != 256) fprintf(stderr, "kernel_launch: %d CUs (the fused epilogues assume 256)\n", grid);
    }
    if (grid < 0) return;
    (void)hipMemsetAsync((char*)d_ws + WS_CTL, 0, CTL_ZERO_BYTES, stream);
    Args a{};
    for (int i = 0; i < 18; ++i) a.in[i] = (const float*)d_in[i];
    a.out = (float*)d_out; a.ws = (unsigned char*)d_ws;
    if (MK_N_LAUNCHES == 1) { a.ph_lo = 0; a.ph_hi = N_PHASES; hipLaunchKernelGGL(mega_fwd, dim3(grid), dim3(NWAVES * 64), LDS_BYTES, stream, a); }
    else for (int p = 0; p < N_PHASES; ++p) { a.ph_lo = p; a.ph_hi = p + 1; hipLaunchKernelGGL(mega_fwd, dim3(grid), dim3(NWAVES * 64), LDS_BYTES, stream, a); }
}
```

```cpp
#include <hip/hip_runtime.h>
#include <cstdio>
#include <cstdint>
constexpr int D = 1024, BATCH = 8, SEQ = 2048, DEPTH = 2, M = BATCH * SEQ;
constexpr int DCONV = 256, DPOOL = 256, DATT = 512, NH = 8, HD = 64, CONVK = 31, DFF = 2816, DIN = 2304, DUP = 2 * DFF;
constexpr float EPS = 1e-6f;
namespace pg8 {
#define PG8_LAS __attribute__((address_space(3)))
typedef unsigned short bf16_t;
typedef short bf16x8 __attribute__((ext_vector_type(8)));
typedef float f32x4 __attribute__((ext_vector_type(4)));
typedef unsigned u32x4 __attribute__((ext_vector_type(4)));
constexpr int BM = 256, BK = 64, HALF = 128, HTB = HALF * BK * 2  , STAGE_BYTES = 8 * HTB, NXCD = 8, WGM = 8;

__host__ __device__ __forceinline__ int lds_byte(int r, int c) { const int st = (r >> 4) * 2 + (c >> 5), rr = r & 15, cc = c & 31, ob = rr * 64 + cc * 2; return st * 1024 + (ob ^ (((ob >> 9) & 1) << 5)); }
__host__ __device__ __forceinline__ void stage_rc(int b, int& R, int& C) { const int st = b / 1024, sb = b % 1024, swz = sb ^ (((sb >> 9) & 1) << 5); R = (st >> 1) * 16 + swz / 64; C = (st & 1) * 32 + (swz % 64) / 2; }
__host__ __device__ __forceinline__ int perm32(int rho) { const int n = rho >> 4, i = rho & 15; return 8 * (i >> 2) + 4 * n + (i & 3); }

struct Unit { int pm, pn; };
struct Gemm { const bf16_t* A; const bf16_t* Bt; int M, N, K; };

struct StaticOrder {
    int nM, nN, nwg, G, c;
    __host__ __device__ void init(int M, int N, int G_, int c_) { nM = M / BM; nN = N / BM; nwg = nM * nN; G = G_; c = c_; }
    __host__ __device__ bool next(int i, Unit& u) const {
        const long L = (long)i * G + c; if (L >= nwg) return false;
        int wgid = (int)L; { const int q = nwg / NXCD, r = nwg % NXCD, xcd = wgid % NXCD, off = wgid / NXCD; wgid = (xcd < r ? xcd * (q + 1) : r * (q + 1) + (xcd - r) * q) + off; }
        const int nig = WGM * nN, gid = wgid / nig, fm = gid * WGM, gsz = (nM - fm) < WGM ? (nM - fm) : WGM;
        u.pm = fm + ((wgid % nig) % gsz); u.pn = (wgid % nig) / gsz; return true;
    }
    __device__ __forceinline__ void a_ready(const Unit&) const {}
    __device__ __forceinline__ void done(const Unit&) const {}
};

__device__ __forceinline__ unsigned cvt_pk_bf16(float lo, float hi) { unsigned r; asm volatile("v_cvt_pk_bf16_f32 %0, %1, %2" : "=v"(r) : "v"(lo), "v"(hi)); return r; }
typedef float f32x2 __attribute__((ext_vector_type(2)));
__device__ __forceinline__ f32x2 gelu_pk(f32x2 v) {
    const f32x2 av = __builtin_elementwise_abs(v), d = av * 0.2316418882f + 1.0f;
    f32x2 t; t.x = __builtin_amdgcn_rcpf(d.x); t.y = __builtin_amdgcn_rcpf(d.y);
    f32x2 q = t * 0.5307027145f + (-0.7265760135f); q = q * t + 0.7107068705f; q = q * t + (-0.142248368f); q = q * t + 0.127414796f; q = q * t;
    const f32x2 s = (v * v) * (-0.72134752044f);
    f32x2 e; e.x = __builtin_amdgcn_exp2f(s.x); e.y = __builtin_amdgcn_exp2f(s.y);
    const f32x2 m = v * (q * e), r = v - m;
    f32x2 o; o.x = v.x < 0.f ? m.x : r.x; o.y = v.y < 0.f ? m.y : r.y; return o;
}
template <int X> __device__ __forceinline__ float swz_xor(float v) { return __builtin_bit_cast(float, __builtin_amdgcn_ds_swizzle(__builtin_bit_cast(int, v), (X << 10) | 0x1f)); }
__device__ __forceinline__ float add_xor32(float v) { float a = v, b = v; asm volatile("s_nop 1\n\tv_permlane32_swap_b32 %0, %1" : "+v"(a), "+v"(b)); return a + b; }
__device__ __forceinline__ float wave_sum_all(float v) { v += swz_xor<1>(v); v += swz_xor<2>(v); v += swz_xor<4>(v); v += swz_xor<8>(v); v += swz_xor<16>(v); return add_xor32(v); }
__device__ __forceinline__ float rs_from_s4(const f32x4 s) { return __builtin_amdgcn_rsqf(((s[0] + s[1]) + (s[2] + s[3])) * (1.0f / 1024.0f) + 1e-6f); }
__device__ __forceinline__ float rs_from_ssp(const float* ssp, int R) { return rs_from_s4(*(const f32x4*)(ssp + (size_t)R * 4)); }
template <int CTRL> __device__ __forceinline__ float dppf(float old, float src) { return __builtin_bit_cast(float, __builtin_amdgcn_update_dpp(__builtin_bit_cast(int, old), __builtin_bit_cast(int, src), CTRL, 0xf, 0xf, false)); }
constexpr int DPP_SHR1 = 0x111, DPP_SHR2 = 0x112, DPP_ROR1 = 0x121, DPP_ROR2 = 0x122;

__device__ __forceinline__ int lane_id_now() { int l; asm volatile("v_mbcnt_lo_u32_b32 %0, -1, 0\n\tv_mbcnt_hi_u32_b32 %0, -1, %0" : "=v"(l)); return l; }
typedef __amdgpu_buffer_rsrc_t rsrc_t;
__device__ __forceinline__ rsrc_t make_rsrc(void* p, unsigned bytes) { return __builtin_amdgcn_make_buffer_rsrc(p, (short)0, (int)bytes, 0x00020000); }
__device__ __forceinline__ void st16_wt(rsrc_t r, unsigned byte_off, u32x4 v) { __builtin_amdgcn_raw_buffer_store_b128(v, r, (int)byte_off, 0, 16); }
struct EpiProj {
    static constexpr bool PERM = true, AFTER_DRAIN = false;
    bf16_t* O; int ldc; const float* ssp;
    __device__ __forceinline__ void operator()(const f32x4 (&acc)[2][2][4][2], const Unit& u, int wr, int wc, int fr, int fq) const {
        { const int l_ = lane_id_now(); fr = l_ & 15; fq = l_ >> 4; }
        const int row0 = u.pm * BM + wr * 64 + fr, col0 = u.pn * BM + wc * 32 + 8 * fq; const rsrc_t ro = make_rsrc(O, 16384u * 2304u * 2u);
        f32x4 s4[2][4];
#pragma unroll
        for (int ai = 0; ai < 2; ++ai)
#pragma unroll
            for (int m = 0; m < 4; ++m) s4[ai][m] = *(const f32x4*)(ssp + (size_t)(row0 + ai * HALF + m * 16) * 4);
#pragma unroll
        for (int ai = 0; ai < 2; ++ai)
#pragma unroll
            for (int m = 0; m < 4; ++m) { const int R = row0 + ai * HALF + m * 16; const float sc = rs_from_s4(s4[ai][m]); const unsigned rowb = ((unsigned)R * (unsigned)ldc + (unsigned)col0) * 2u;
#pragma unroll
                for (int bj = 0; bj < 2; ++bj) { const f32x4 v0 = acc[ai][bj][m][0] * sc, v1 = acc[ai][bj][m][1] * sc;
                    u32x4 w; w.x = cvt_pk_bf16(v0[0], v0[1]); w.y = cvt_pk_bf16(v0[2], v0[3]); w.z = cvt_pk_bf16(v1[0], v1[1]); w.w = cvt_pk_bf16(v1[2], v1[3]);
                    st16_wt(ro, rowb + bj * HALF * 2, w); } }
    }
};
struct EpiUp {
    static constexpr bool PERM = true, AFTER_DRAIN = false;
    bf16_t* H; const float* ssp; const float* dww; const float* dwb; PG8_LAS float* xl;
    __device__ __forceinline__ void operator()(f32x4 (&acc)[2][2][4][2], const Unit& u, int wr, int wc, int fr, int fq) const {
        { const int l_ = lane_id_now(); fr = l_ & 15; fq = l_ >> 4; asm volatile("" : "+s"(wr), "+s"(wc)); }
        const bool halo = (u.pm == 64); const rsrc_t rh = make_rsrc(H, 16384u * 2816u * 2u);
        const int ch0 = u.pn * HALF + wc * 32 + 8 * fq;
        f32x4 s4[2][4];
#pragma unroll
        for (int ai = 0; ai < 2; ++ai)
#pragma unroll
            for (int m = 0; m < 4; ++m) { const int rt = ai * HALF + wr * 64 + m * 16 + fr; int R = halo ? 256 * (rt >> 2) - 2 + (rt & 3) : u.pm * BM + rt; R = R < 0 ? 0 : R; s4[ai][m] = *(const f32x4*)(ssp + (size_t)R * 4); }
#pragma unroll
        for (int ai = 0; ai < 2; ++ai)
#pragma unroll
            for (int m = 0; m < 4; ++m) {
                const float sc = rs_from_s4(s4[ai][m]);
#pragma unroll
                for (int bj = 0; bj < 2; ++bj)
#pragma unroll
                    for (int n = 0; n < 2; ++n) acc[ai][bj][m][n] *= sc; }
        if (fr >= 14) {
#pragma unroll
            for (int ai = 0; ai < 2; ++ai)
#pragma unroll
                for (int n = 0; n < 2; ++n) *(PG8_LAS f32x4*)(xl + ((ai * 2 + wr) * 4 + wc) * 64 + (fr - 14) * 32 + fq * 8 + n * 4) = acc[ai][1][3][n]; }
        asm volatile("s_waitcnt lgkmcnt(0)" ::: "memory"); __builtin_amdgcn_s_barrier(); asm volatile("" ::: "memory");
        f32x4 w0[2], w1[2], w2[2], bb[2];
#pragma unroll
        for (int n = 0; n < 2; ++n) { w0[n] = *(const f32x4*)(dww + ch0 + 4 * n); w1[n] = *(const f32x4*)(dww + DFF + ch0 + 4 * n); w2[n] = *(const f32x4*)(dww + 2 * DFF + ch0 + 4 * n); bb[n] = *(const f32x4*)(dwb + ch0 + 4 * n); }
#pragma unroll
        for (int ai = 0; ai < 2; ++ai)
#pragma unroll
            for (int m = 0; m < 4; ++m) {
                f32x4 prev[2];
                if (m > 0) { prev[0] = acc[ai][1][m - 1][0]; prev[1] = acc[ai][1][m - 1][1]; }
                else { prev[0] = (f32x4){0.f, 0.f, 0.f, 0.f}; prev[1] = prev[0];
                    const int sai = wr ? ai : ai - 1, swr = wr ? 0 : 1;
                    if (!halo && sai >= 0 && fr >= 14) {
#pragma unroll
                        for (int n = 0; n < 2; ++n) prev[n] = *(const PG8_LAS f32x4*)(xl + ((sai * 2 + swr) * 4 + wc) * 64 + (fr - 14) * 32 + fq * 8 + n * 4); } }
                f32x4 hv[2];
#pragma unroll
                for (int n = 0; n < 2; ++n) { const f32x4 cur = acc[ai][1][m][n]; f32x4 g1, g2;
#pragma unroll
                    for (int i = 0; i < 4; ++i) { const float p1 = halo ? 0.f : dppf<DPP_ROR1>(0.f, prev[n][i]), p2 = halo ? 0.f : dppf<DPP_ROR2>(0.f, prev[n][i]);
                        g1[i] = dppf<DPP_SHR1>(p1, cur[i]); g2[i] = dppf<DPP_SHR2>(p2, cur[i]); }
                    const f32x4 gc = w0[n] * g2 + w1[n] * g1 + w2[n] * cur + bb[n];
                    const f32x2 ga = gelu_pk((f32x2){gc[0], gc[1]}), gb = gelu_pk((f32x2){gc[2], gc[3]});
                    hv[n] = acc[ai][0][m][n] * (f32x4){ga.x, ga.y, gb.x, gb.y}; }
                const int rt = ai * HALF + wr * 64 + m * 16 + fr;
                u32x4 w; w.x = cvt_pk_bf16(hv[0][0], hv[0][1]); w.y = cvt_pk_bf16(hv[0][2], hv[0][3]); w.z = cvt_pk_bf16(hv[1][0], hv[1][1]); w.w = cvt_pk_bf16(hv[1][2], hv[1][3]);
                if (!halo) { if (!(rt < 2 && (u.pm & 7) != 0)) st16_wt(rh, ((unsigned)(u.pm * BM + rt) * (unsigned)DFF + (unsigned)ch0) * 2u, w); }
                else { const int k = rt >> 2, j = rt & 3; if (j >= 2 && (k & 7) != 0) st16_wt(rh, ((unsigned)(256 * k + j - 2) * (unsigned)DFF + (unsigned)ch0) * 2u, w); }
            }
    }
};
struct EpiRes {
    static constexpr bool PERM = true, AFTER_DRAIN = true;
    bf16_t* XB; const float* bias; float* sspo;
    __device__ __forceinline__ void fused(f32x4 (&acc)[2][2][4][2], const Unit& u, int wr, int wc, int fr, int fq, PG8_LAS unsigned char* lds, int wid, int lane) const {
        PG8_LAS float* P = (PG8_LAS float*)lds;
        { const int l_ = lane_id_now(); fr = l_ & 15; fq = l_ >> 4; lane = l_; }
        const int col0 = u.pn * BM + wc * 32 + 8 * fq; const rsrc_t rx = make_rsrc(XB, (16384u + 256u) * 1024u * 2u);
        f32x4 bv[2][2];
#pragma unroll
        for (int bj = 0; bj < 2; ++bj)
#pragma unroll
            for (int n = 0; n < 2; ++n) bv[bj][n] = bias ? *(const f32x4*)(bias + col0 + bj * HALF + 4 * n) : (f32x4){0.f, 0.f, 0.f, 0.f};
        u32x4 xin[2][4][2];
#pragma unroll
        for (int ai = 0; ai < 2; ++ai)
#pragma unroll
            for (int m = 0; m < 4; ++m)
#pragma unroll
                for (int bj = 0; bj < 2; ++bj) xin[ai][m][bj] = __builtin_amdgcn_raw_buffer_load_b128(rx, (int)(((unsigned)(u.pm * BM + ai * HALF + wr * 64 + m * 16 + fr) * 1024u + (unsigned)col0) * 2u + bj * HALF * 2), 0, 0);
#pragma unroll
        for (int ai = 0; ai < 2; ++ai)
#pragma unroll
            for (int m = 0; m < 4; ++m) { const int rt = ai * HALF + wr * 64 + m * 16 + fr, R = u.pm * BM + rt; const unsigned off = ((unsigned)R * 1024u + (unsigned)col0) * 2u; float s = 0.f;
                int hr = -1; if (rt < 2) hr = 16384 + 4 * u.pm + 2 + rt; else if (rt >= 254) hr = 16384 + 4 * (u.pm + 1) + (rt - 254);
#pragma unroll
                for (int bj = 0; bj < 2; ++bj) { const u32x4 xb = xin[ai][m][bj];
                    f32x4 x0, x1;
                    x0[0] = __builtin_bit_cast(float, xb[0] << 16); x0[1] = __builtin_bit_cast(float, xb[0] & 0xffff0000u); x0[2] = __builtin_bit_cast(float, xb[1] << 16); x0[3] = __builtin_bit_cast(float, xb[1] & 0xffff0000u);
                    x1[0] = __builtin_bit_cast(float, xb[2] << 16); x1[1] = __builtin_bit_cast(float, xb[2] & 0xffff0000u); x1[2] = __builtin_bit_cast(float, xb[3] << 16); x1[3] = __builtin_bit_cast(float, xb[3] & 0xffff0000u);
                    x0 = x0 + acc[ai][bj][m][0] + bv[bj][0]; x1 = x1 + acc[ai][bj][m][1] + bv[bj][1];
                    s += ((x0[0] * x0[0] + x0[1] * x0[1]) + (x0[2] * x0[2] + x0[3] * x0[3])) + ((x1[0] * x1[0] + x1[1] * x1[1]) + (x1[2] * x1[2] + x1[3] * x1[3]));
                    u32x4 w; w.x = cvt_pk_bf16(x0[0], x0[1]); w.y = cvt_pk_bf16(x0[2], x0[3]); w.z = cvt_pk_bf16(x1[0], x1[1]); w.w = cvt_pk_bf16(x1[2], x1[3]);
                    st16_wt(rx, off + bj * HALF * 2, w);
                    if (hr >= 0 && hr < 16384 + 256) st16_wt(rx, ((unsigned)hr * 1024u + (unsigned)col0) * 2u + bj * HALF * 2, w); }
                s += swz_xor<16>(s); s = add_xor32(s);
                if (fq == 0) P[rt * 4 + wc] = s; }
        asm volatile("s_waitcnt lgkmcnt(0)" ::: "memory"); __builtin_amdgcn_s_barrier(); asm volatile("" ::: "memory");
        const int tid = wid * 64 + lane;
        if (tid < 256) { const f32x4 p = *(const PG8_LAS f32x4*)(P + tid * 4); sspo[(size_t)(u.pm * BM + tid) * 4 + u.pn] = (p[0] + p[1]) + (p[2] + p[3]); }
        asm volatile("s_waitcnt lgkmcnt(0)" ::: "memory"); __builtin_amdgcn_s_barrier(); asm volatile("" ::: "memory");
    }
};
template <class Epi, class Sched, bool ALIGN_EPI = false, bool SP2 = false>
__device__ __forceinline__ void gemm_phase(PG8_LAS unsigned char* lds, const Gemm g, const Sched& S, const Epi& E, int wave_id  ) {
    int tid_; asm volatile("v_mbcnt_lo_u32_b32 %0, -1, 0\n\tv_mbcnt_hi_u32_b32 %0, -1, %0" : "=v"(tid_)); tid_ += 64 * wave_id;
    const int tid = tid_, wid = __builtin_amdgcn_readfirstlane(tid >> 6), lane = tid & 63, wr = wid >> 2, wc = wid & 3, fr = lane & 15, fq = lane >> 4;
    const int K = g.K, nt = K / BK;
    unsigned voffA[2], voffB[2];
#pragma unroll
    for (int i = 0; i < 2; ++i) { int R, C; stage_rc(tid * 16 + i * 8192, R, C); const int Rb = Epi::PERM ? ((R & ~31) + perm32(R & 31)) : R;
        voffA[i] = (unsigned)(R * K + C) * 2u; voffB[i] = (unsigned)(Rb * K + C) * 2u; }
    const size_t kstep = (size_t)(BK * 2);
    const size_t hstep = (size_t)HALF * K * 2;
    const size_t tstep = 2 * hstep;
    const unsigned ldsw = (unsigned)wid * 1024u;
    const int aoff = lds_byte(wr * 64 + fr, fq * 8), boff = lds_byte(wc * 32 + fr, fq * 8);
#define PG8_SA(b, h) (((b) * 2 + (h)) * HTB)
#define PG8_SB(b, h) ((4 + (b) * 2 + (h)) * HTB)
#define PG8_STAGE(bufoff, gbase, voff) do { _Pragma("unroll") for (int _i = 0; _i < 2; ++_i) \
        __builtin_amdgcn_global_load_lds((const unsigned*)((const char*)(gbase) + (voff)[_i]), (PG8_LAS unsigned*)(lds + (bufoff) + ldsw + _i * 8192), 16, 0, 0); } while (0)
#define PG8_LDA(dst, b, h) do { _Pragma("unroll") for (int m = 0; m < 4; ++m) _Pragma("unroll") for (int k = 0; k < 2; ++k) dst[m][k] = *(const PG8_LAS bf16x8*)(lds + PG8_SA(b, h) + aoff + m * 2048 + k * 1024); } while (0)
#define PG8_LDB(dst, b, h) do { _Pragma("unroll") for (int n = 0; n < 2; ++n) _Pragma("unroll") for (int k = 0; k < 2; ++k) dst[n][k] = *(const PG8_LAS bf16x8*)(lds + PG8_SB(b, h) + boff + n * 2048 + k * 1024); } while (0)
#define PG8_MMA(ai, bj, At, Bt) do { __builtin_amdgcn_s_setprio(1); _Pragma("unroll") for (int m = 0; m < 4; ++m) _Pragma("unroll") for (int n = 0; n < 2; ++n) _Pragma("unroll") for (int k = 0; k < 2; ++k) \
        acc[ai][bj][m][n] = __builtin_amdgcn_mfma_f32_16x16x32_bf16(Bt[n][k], At[m][k], acc[ai][bj][m][n], 0, 0, 0); __builtin_amdgcn_s_setprio(0); } while (0)
#define PG8_WAIT_V(n) asm volatile("s_waitcnt vmcnt(" #n ")" ::: "memory")
#define PG8_WAIT_L(n) asm volatile("s_waitcnt lgkmcnt(" #n ")" ::: "memory")
#define PG8_BAR __builtin_amdgcn_s_barrier()
#define PG8_SCHED __builtin_amdgcn_sched_barrier(0)
    Unit cur, nxt; int ui = 0;
    if (!S.next(0, cur)) return;
    f32x4 acc[2][2][4][2];
#pragma unroll
    for (int a = 0; a < 2; ++a)
#pragma unroll
        for (int b = 0; b < 2; ++b)
#pragma unroll
            for (int m = 0; m < 4; ++m)
#pragma unroll
                for (int n = 0; n < 2; ++n) acc[a][b][m][n] = (f32x4){0.f, 0.f, 0.f, 0.f};
    bf16x8 At[4][2], B0[2][2], B1[2][2];
    const char* cA = (const char*)g.A + (size_t)cur.pm * tstep; const char* cB = (const char*)g.Bt + (size_t)cur.pn * tstep;
    S.a_ready(cur);
    if constexpr (SP2) {
        PG8_STAGE(PG8_SB(0, 0), cB, voffB); PG8_STAGE(PG8_SB(0, 1), cB + hstep, voffB); PG8_STAGE(PG8_SA(0, 0), cA, voffA); PG8_STAGE(PG8_SA(0, 1), cA + hstep, voffA);
        if (wr == 1) PG8_BAR;
        PG8_WAIT_V(2); PG8_BAR;
        PG8_STAGE(PG8_SB(1, 0), cB + kstep, voffB); PG8_STAGE(PG8_SA(1, 0), cA + kstep, voffA); PG8_STAGE(PG8_SB(1, 1), cB + hstep + kstep, voffB);
        PG8_WAIT_V(6); PG8_BAR;
    } else {
        PG8_STAGE(PG8_SB(0, 0), cB, voffB); PG8_STAGE(PG8_SA(0, 0), cA, voffA); PG8_STAGE(PG8_SB(0, 1), cB + hstep, voffB); PG8_STAGE(PG8_SA(0, 1), cA + hstep, voffA);
        if (wr == 1) PG8_BAR;
        PG8_WAIT_V(4); PG8_BAR;
        PG8_STAGE(PG8_SB(1, 0), cB + kstep, voffB); PG8_STAGE(PG8_SA(1, 0), cA + kstep, voffA); PG8_STAGE(PG8_SB(1, 1), cB + hstep + kstep, voffB);
        PG8_WAIT_V(6); PG8_BAR;
    }
#ifdef DBG_GEMM_T
    volatile PG8_LAS unsigned long long* GT = (volatile PG8_LAS unsigned long long*)(lds + 135488 + 512); const bool gt_on = (blockIdx.x == 0 && tid == 0); unsigned long long gt0 = 0;
#endif
    for (;;) {
#ifdef DBG_GEMM_T
        if (gt_on) gt0 = __builtin_amdgcn_s_memrealtime();
#endif
        const bool has_next = S.next(ui + 1, nxt);
        const char* nA = has_next ? (const char*)g.A + (size_t)nxt.pm * tstep : cA; const char* nB = has_next ? (const char*)g.Bt + (size_t)nxt.pn * tstep : cB;
        for (int t = 0; t < nt; t += 2) {
            const bool last = (t == nt - 2);
            const char* a1 = cA + (size_t)(t + 1) * kstep;
            const char* a2 = last ? nA : cA + (size_t)(t + 2) * kstep; const char* b2 = last ? nB : cB + (size_t)(t + 2) * kstep;
            const char* a3 = a2 + kstep; const char* b3 = b2 + kstep;
            if (last && has_next) S.a_ready(nxt);
            if constexpr (SP2) {
            PG8_LDB(B0, 0, 0); PG8_LDB(B1, 0, 1); PG8_SCHED; PG8_LDA(At, 0, 0); PG8_STAGE(PG8_SA(1, 1), a1 + hstep, voffA);
            PG8_WAIT_V(8); PG8_WAIT_L(0); PG8_BAR; PG8_MMA(0, 0, At, B0); PG8_MMA(0, 1, At, B1); PG8_BAR; PG8_SCHED;
            PG8_LDA(At, 0, 1); PG8_STAGE(PG8_SB(0, 0), b2, voffB); PG8_STAGE(PG8_SB(0, 1), b2 + hstep, voffB); PG8_STAGE(PG8_SA(0, 0), a2, voffA);
            PG8_WAIT_V(8); PG8_WAIT_L(0); PG8_BAR; PG8_MMA(1, 0, At, B0); PG8_MMA(1, 1, At, B1); PG8_BAR; PG8_SCHED;
            PG8_LDB(B0, 1, 0); PG8_LDB(B1, 1, 1); PG8_SCHED; PG8_LDA(At, 1, 0); PG8_STAGE(PG8_SA(0, 1), a2 + hstep, voffA);
            PG8_WAIT_V(8); PG8_WAIT_L(0); PG8_BAR; PG8_MMA(0, 0, At, B0); PG8_MMA(0, 1, At, B1); PG8_BAR; PG8_SCHED;
            PG8_LDA(At, 1, 1); PG8_STAGE(PG8_SB(1, 0), b3, voffB); PG8_STAGE(PG8_SB(1, 1), b3 + hstep, voffB); PG8_STAGE(PG8_SA(1, 0), a3, voffA);
            PG8_WAIT_V(8); PG8_WAIT_L(0); PG8_BAR; PG8_MMA(1, 0, At, B0); PG8_MMA(1, 1, At, B1); PG8_BAR; PG8_SCHED;
            } else {
            PG8_LDB(B0, 0, 0); PG8_SCHED; PG8_LDA(At, 0, 0); PG8_STAGE(PG8_SA(1, 1), a1 + hstep, voffA);
            PG8_WAIT_L(8); PG8_BAR; PG8_WAIT_L(0); PG8_MMA(0, 0, At, B0); PG8_BAR; PG8_SCHED;
            PG8_LDB(B1, 0, 1); PG8_STAGE(PG8_SB(0, 0), b2, voffB);
            PG8_BAR; PG8_WAIT_L(0); PG8_MMA(0, 1, At, B1); PG8_BAR;
            PG8_LDA(At, 0, 1); PG8_STAGE(PG8_SA(0, 0), a2, voffA);
            PG8_BAR; PG8_WAIT_L(0); PG8_MMA(1, 0, At, B0); PG8_BAR; PG8_SCHED;
            PG8_STAGE(PG8_SB(0, 1), b2 + hstep, voffB);
            PG8_WAIT_V(6); PG8_BAR; PG8_MMA(1, 1, At, B1); PG8_BAR;
            PG8_LDB(B0, 1, 0); PG8_SCHED; PG8_LDA(At, 1, 0); PG8_STAGE(PG8_SA(0, 1), a2 + hstep, voffA);
            PG8_WAIT_L(8); PG8_BAR; PG8_WAIT_L(0); PG8_MMA(0, 0, At, B0); PG8_BAR; PG8_SCHED;
            PG8_LDB(B1, 1, 1); PG8_STAGE(PG8_SB(1, 0), b3, voffB);
            PG8_BAR; PG8_WAIT_L(0); PG8_MMA(0, 1, At, B1); PG8_BAR;
            PG8_LDA(At, 1, 1); PG8_STAGE(PG8_SA(1, 0), a3, voffA);
            PG8_BAR; PG8_WAIT_L(0); PG8_MMA(1, 0, At, B0); PG8_BAR; PG8_SCHED;
            PG8_STAGE(PG8_SB(1, 1), b3 + hstep, voffB);
            PG8_WAIT_V(6); PG8_BAR; PG8_MMA(1, 1, At, B1); PG8_BAR;
            }
        }
        if constexpr (ALIGN_EPI) { if (wr == 0) PG8_BAR; }
#ifdef DBG_GEMM_T
        if (gt_on) { const unsigned long long t1 = __builtin_amdgcn_s_memrealtime(); GT[0] += t1 - gt0; gt0 = t1; }
#endif
        if constexpr (!Epi::AFTER_DRAIN) { E(acc, cur, wr, wc, fr, fq); S.done(cur); }
#ifdef DBG_GEMM_T
        if (gt_on) { const unsigned long long t1 = __builtin_amdgcn_s_memrealtime(); GT[1] += t1 - gt0; }
#endif
        if (!has_next) break;
#pragma unroll
        for (int a = 0; a < 2; ++a)
#pragma unroll
            for (int b = 0; b < 2; ++b)
#pragma unroll
                for (int m = 0; m < 4; ++m)
#pragma unroll
                    for (int n = 0; n < 2; ++n) acc[a][b][m][n] = (f32x4){0.f, 0.f, 0.f, 0.f};
        cur = nxt; cA = nA; cB = nB; ++ui;
        if constexpr (ALIGN_EPI) { if (wr == 1) PG8_BAR; }
    }
    PG8_WAIT_V(0);
    if constexpr (!ALIGN_EPI) { if (wr == 0) PG8_BAR; }
    PG8_BAR;
    if constexpr (Epi::AFTER_DRAIN) { E.fused(acc, cur, wr, wc, fr, fq, lds, wid, lane); S.done(cur); }
#undef PG8_SA
#undef PG8_SB
#undef PG8_STAGE
#undef PG8_LDA
#undef PG8_LDB
#undef PG8_MMA
#undef PG8_WAIT_V
#undef PG8_WAIT_L
#undef PG8_BAR
#undef PG8_SCHED
}
}

#ifndef PG8_SP2
#define PG8_SP2 true
#endif
#ifndef PG8_ALIGN
#define PG8_ALIGN true
#endif
#define GAS __attribute__((address_space(1)))
#define LAS __attribute__((address_space(3)))
typedef unsigned short bf16;
typedef unsigned v4u __attribute__((ext_vector_type(4)));
typedef float f32x4 __attribute__((ext_vector_type(4)));
typedef short bf16x8 __attribute__((ext_vector_type(8)));
typedef GAS unsigned gu32;
typedef GAS unsigned long long gu64;
#define RLX_AGENT __ATOMIC_RELAXED, __HIP_MEMORY_SCOPE_AGENT
#define LDS_WAIT() asm volatile("s_waitcnt lgkmcnt(0)" ::: "memory")
#define VM_WAIT() asm volatile("s_waitcnt vmcnt(0)" ::: "memory")
__device__ __forceinline__ unsigned long long rt() { return __builtin_amdgcn_s_memrealtime(); }
__device__ __forceinline__ unsigned f2bf(float f) { unsigned u = __builtin_bit_cast(unsigned, f); return (u + 0x7fffu + ((u >> 16) & 1u)) >> 16; }
__device__ __forceinline__ unsigned pk2(float lo, float hi) { return f2bf(lo) | (f2bf(hi) << 16); }

#define XB_TMO      128
#define XB_XCNT(j)  (256  + 64 * (j))
#define XB_XSUB(j)  (1280 + 64 * (j))
#define XB_XGEN(j)  (2304 + 64 * (j))
#define XB_TOP      3328
#define XB_TOPGEN   3392
#define XCD_BAR_WORDS 3456
#define XB_SPIN_CAP (1u << 18)

__device__ __forceinline__ unsigned xb_ld(unsigned* p)              { return __hip_atomic_load(p, __ATOMIC_RELAXED, __HIP_MEMORY_SCOPE_AGENT); }
__device__ __forceinline__ unsigned xb_add(unsigned* p, unsigned v) { return __hip_atomic_fetch_add(p, v, __ATOMIC_RELAXED, __HIP_MEMORY_SCOPE_AGENT); }
__device__ __forceinline__ unsigned xb_xcc_id() { return (unsigned)__builtin_amdgcn_s_getreg((3 << 11) | 20) & 0xFu; }
#define XB_SPIN(cond, bar) do { unsigned _sp = 0; while (cond) { __builtin_amdgcn_s_sleep(1); \
    if ((++_sp & 255u) == 0u) { if (xb_ld(&(bar)[XB_TMO])) break; if (_sp > XB_SPIN_CAP) { atomicAdd(&(bar)[XB_TMO], 1u); break; } } } } while (0)

struct XcdBarrier {
    unsigned* bar; unsigned x;
    volatile LAS unsigned* st;
};

__device__ __forceinline__ XcdBarrier xcd_barrier_post(unsigned* bar, volatile LAS unsigned* st) {
    XcdBarrier b; b.bar = bar; b.x = xb_xcc_id(); b.st = st;
    if (threadIdx.x == 0) (void)xb_add(&bar[XB_XCNT(b.x)], 1u);
    return b;
}
__device__ __forceinline__ void xcd_barrier_complete(unsigned* bar, unsigned x, unsigned& nloc, unsigned& nx) {
    const unsigned G = gridDim.x * gridDim.y * gridDim.z;
    unsigned sum, cnt, mine, sp = 0u;
    for (;;) {
        sum = 0u; cnt = 0u; mine = 0u;
#pragma unroll
        for (unsigned j = 0; j < 16; ++j) { const unsigned c = xb_ld(&bar[XB_XCNT(j)]); sum += c; cnt += (c > 0u) ? 1u : 0u; }
        mine = xb_ld(&bar[XB_XCNT(x)]);
        if (sum == G) break;
        __builtin_amdgcn_s_sleep(1);
        if ((++sp & 255u) == 0u) { if (xb_ld(&bar[XB_TMO])) break; if (sp > XB_SPIN_CAP) { atomicAdd(&bar[XB_TMO], 1u); break; } }
    }
    nloc = mine > 0u ? mine : 1u; nx = cnt > 0u ? cnt : 1u;
}

__device__ __forceinline__ void xcd_barrier(const XcdBarrier& b) {
    asm volatile("s_waitcnt vmcnt(0)" ::: "memory");
    __syncthreads();
    if (threadIdx.x == 0) {
        unsigned* bar = b.bar;
        __builtin_amdgcn_s_waitcnt(0);
        unsigned nloc = b.st[0], nx = b.st[1];
        if (nloc == 0u) { xcd_barrier_complete(bar, b.x, nloc, nx); b.st[0] = nloc; b.st[1] = nx; }
        const unsigned old = xb_add(&bar[XB_XSUB(b.x)], 1u);
        const unsigned gen = old / nloc;
        if (old + 1u == (gen + 1u) * nloc) {
            __builtin_amdgcn_fence(__ATOMIC_RELEASE, "agent");
            asm volatile("s_waitcnt vmcnt(0)" ::: "memory");
            const unsigned og = xb_add(&bar[XB_TOP], 1u);
            const unsigned tg = og / nx;
            if (og + 1u == (tg + 1u) * nx) xb_add(&bar[XB_TOPGEN], 1u);
            else XB_SPIN(xb_ld(&bar[XB_TOPGEN]) == tg, bar);
            __builtin_amdgcn_fence(__ATOMIC_ACQUIRE, "agent");
            xb_add(&bar[XB_XGEN(b.x)], 1u);
            asm volatile("s_waitcnt vmcnt(0)" ::: "memory");
        } else {
            XB_SPIN(xb_ld(&bar[XB_XGEN(b.x)]) == gen, bar);
            __builtin_amdgcn_fence(__ATOMIC_ACQUIRE, "agent");
            asm volatile("s_waitcnt vmcnt(0)" ::: "memory");
        }
    }
    __syncthreads();
}

namespace sba {
typedef short bf16x8 __attribute__((ext_vector_type(8)));
typedef short s16x4 __attribute__((ext_vector_type(4)));
typedef float f32x16 __attribute__((ext_vector_type(16)));
typedef unsigned u32x4 __attribute__((ext_vector_type(4)));
constexpr int PITCH = DIN, QOFF = 768, KOFF = 1280, VOFF = 1792, MIXOFF = 512;
constexpr int SLOTB = 8192, LDS_K = 0, LDS_V = 2 * SLOTB, LDS_OST = 4 * SLOTB, LDS_FLG = LDS_OST + 8 * 4096, LDS_BYTES_ATT = LDS_FLG + 64;
constexpr float CARRY_ZERO = 152.0f;
__device__ __forceinline__ int crow(int r, int hi) { return (r & 3) + 8 * (r >> 2) + 4 * hi; }
__device__ __forceinline__ void glds16(const void* gsrc, unsigned lds_dst) { unsigned keep;
    asm volatile("s_mov_b32 %0, m0\n\ts_mov_b32 m0, %2\n\ts_nop 0\n\tglobal_load_lds_dwordx4 %1, off\n\ts_mov_b32 m0, %0" : "=&s"(keep) : "v"(gsrc), "s"(lds_dst) : "memory"); }
typedef float f32x2_t __attribute__((ext_vector_type(2))); typedef __bf16 bf16x2_t __attribute__((ext_vector_type(2)));
__device__ __forceinline__ unsigned cvtpk_s(float lo, float hi) { f32x2_t v = {lo, hi}; bf16x2_t b = __builtin_convertvector(v, bf16x2_t); return __builtin_bit_cast(unsigned, b); }
#define SBA_WAIT_BAR() asm volatile("s_waitcnt vmcnt(0) lgkmcnt(0)\n\ts_barrier" ::: "memory")
#define SBA_SBAR() __builtin_amdgcn_sched_barrier(0)
typedef __attribute__((address_space(3))) const char* lds_cptr;
__device__ __forceinline__ void kload8(bf16x8* kf, lds_cptr kp) {
    kf[0] = *(const __attribute__((address_space(3))) bf16x8*)(kp);        kf[1] = *(const __attribute__((address_space(3))) bf16x8*)(kp + 512);
    kf[2] = *(const __attribute__((address_space(3))) bf16x8*)(kp + 2048); kf[3] = *(const __attribute__((address_space(3))) bf16x8*)(kp + 2560);
    kf[4] = *(const __attribute__((address_space(3))) bf16x8*)(kp + 4096); kf[5] = *(const __attribute__((address_space(3))) bf16x8*)(kp + 4608);
    kf[6] = *(const __attribute__((address_space(3))) bf16x8*)(kp + 6144); kf[7] = *(const __attribute__((address_space(3))) bf16x8*)(kp + 6656);
}
#define SBA_MFMA(a, b, c) __builtin_amdgcn_mfma_f32_32x32x16_bf16((a), (b), (c), 0, 0, 0)
__device__ __forceinline__ void pv(f32x16* o, int vb, bf16x8 pa0, bf16x8 pa1, bf16x8 pa2, bf16x8 pa3) {
#pragma unroll
    for (int d0 = 0; d0 < 2; ++d0) { s16x4 lo[4], hi[4];
#pragma unroll
        for (int ks = 0; ks < 4; ++ks) {
            asm volatile("ds_read_b64_tr_b16 %0,%1 offset:%c2" : "=&v"(lo[ks]) : "v"(vb), "i"(d0 * 4096 + ks * 1024) : "memory");
            asm volatile("ds_read_b64_tr_b16 %0,%1 offset:%c2" : "=&v"(hi[ks]) : "v"(vb), "i"(d0 * 4096 + ks * 1024 + 512) : "memory"); }
        asm volatile("s_waitcnt lgkmcnt(0)" ::: "memory"); SBA_SBAR();
#define SBA_PK(k) (bf16x8){lo[k][0], lo[k][1], lo[k][2], lo[k][3], hi[k][0], hi[k][1], hi[k][2], hi[k][3]}
        o[d0] = SBA_MFMA(pa0, SBA_PK(0), o[d0]); o[d0] = SBA_MFMA(pa1, SBA_PK(1), o[d0]); o[d0] = SBA_MFMA(pa2, SBA_PK(2), o[d0]); o[d0] = SBA_MFMA(pa3, SBA_PK(3), o[d0]);
#undef SBA_PK
    }
}
__device__ __forceinline__ bf16x8 pack8(const f32x16& x, int b) { u32x4 p; p[0] = cvtpk_s(x[b], x[b + 1]); p[1] = cvtpk_s(x[b + 2], x[b + 3]); p[2] = cvtpk_s(x[b + 4], x[b + 5]); p[3] = cvtpk_s(x[b + 6], x[b + 7]); return __builtin_bit_cast(bf16x8, p); }

__device__ __forceinline__ void attn_unit(int b, int h, int qb, const unsigned short* PROJ, unsigned short* MIX, char* shm, int wid, int lane) {
    const int r32 = lane & 31, hi = lane >> 5;
    const long rowbase = (long)b * SEQ; const int q0 = qb * 256;
    const unsigned short* Qw = PROJ + (rowbase + q0 + wid * 32) * PITCH + QOFF + h * 64;
    const unsigned short* Kh = PROJ + rowbase * PITCH + KOFF + h * 64; const unsigned short* Vh = PROJ + rowbase * PITCH + VOFF + h * 64;
    const unsigned lds0 = (unsigned)(uintptr_t)shm;
    const unsigned short* ksrc = Kh + (long)lane * PITCH + wid * 8;
    const unsigned short* vsrc = Vh + (long)(16 * (wid & 3) + (lane >> 2)) * PITCH + (wid >> 2) * 32 + (lane & 3) * 8;
    const unsigned kdst = lds0 + LDS_K + wid * 1024, vdst = lds0 + LDS_V + wid * 1024;
#define SBA_DMA(t, slot) do { glds16(ksrc + (long)(t) * 64 * PITCH, (unsigned)__builtin_amdgcn_readfirstlane(kdst + (slot))); glds16(vsrc + (long)(t) * 64 * PITCH, (unsigned)__builtin_amdgcn_readfirstlane(vdst + (slot))); } while (0)
    const int vb0 = (int)(lds0 + LDS_V) + ((lane >> 4) & 1) * 32 + (lane & 3) * 8 + (4 * hi + ((lane & 15) >> 2)) * 64;
    const lds_cptr kp0 = (lds_cptr)shm + LDS_K + hi * 1024 + r32 * 16;
    const int NT = 4 * (qb + 1);
    SBA_DMA(NT - 1, 0);
    bf16x8 qr[4];
#pragma unroll
    for (int d0 = 0; d0 < 4; ++d0) qr[d0] = *reinterpret_cast<const bf16x8*>(&Qw[(long)r32 * PITCH + d0 * 16 + hi * 8]);
    bf16x8 U0, U1, J;
#pragma unroll
    for (int j = 0; j < 8; ++j) { const int k0 = 8 * (j >> 2) + 4 * hi + (j & 3); U0[j] = (k0 >= r32) ? (short)0x3F80 : (short)0; U1[j] = (16 + k0 >= r32) ? (short)0x3F80 : (short)0; J[j] = (short)0x3F80; }
    f32x16 C, o[2];
#pragma unroll
    for (int r = 0; r < 16; ++r) { C[r] = 0.f; o[0][r] = 0.f; o[1][r] = 0.f; }
    const int qrel = wid * 32 + r32;
    volatile __attribute__((address_space(3))) int* flg = (volatile __attribute__((address_space(3))) int*)((lds_cptr)shm + LDS_FLG);
    if (lane == 0) flg[wid] = 0x7fffffff;
    bool wdone = false;
    SBA_WAIT_BAR();
    for (int i = 0; i < NT; ++i) {
        const int t = NT - 1 - i, slot = (i & 1) * SLOTB, jb = t - 4 * qb;
        if (i + 1 < NT) SBA_DMA(t - 1, slot ^ SLOTB);
        if (!wdone && !(jb >= 0 && 2 * jb > wid)) {
            bf16x8 kf[8]; kload8(kf, kp0 + slot);
            f32x16 z0, z1;
#pragma unroll
            for (int r = 0; r < 16; ++r) { z0[r] = 0.f; z1[r] = 0.f; }
#pragma unroll
            for (int s = 0; s < 4; ++s) { z0 = SBA_MFMA(kf[2 * s], qr[s], z0); z1 = SBA_MFMA(kf[2 * s + 1], qr[s], z1); }
            if (jb >= 0) { const int kb = 64 * jb + 4 * hi;
#pragma unroll
                for (int r = 0; r < 16; ++r) { const int kv = kb + (r & 3) + 8 * (r >> 2); if (kv >= qrel) z0[r] = -INFINITY; if (kv + 32 >= qrel) z1[r] = -INFINITY; } }
            f32x16 s0, s1;
#pragma unroll
            for (int r = 0; r < 16; ++r) { s0[r] = fmaxf(z0[r], 0.f) + __builtin_amdgcn_logf(1.0f + __builtin_amdgcn_exp2f(-fabsf(z0[r]))); s1[r] = fmaxf(z1[r], 0.f) + __builtin_amdgcn_logf(1.0f + __builtin_amdgcn_exp2f(-fabsf(z1[r]))); }
            const bf16x8 f00 = pack8(s0, 0), f01 = pack8(s0, 8), f10 = pack8(s1, 0), f11 = pack8(s1, 8);
            f32x16 Dv = SBA_MFMA(J, f10, C); Dv = SBA_MFMA(J, f11, Dv);
            f32x16 c1 = SBA_MFMA(U0, f10, C); c1 = SBA_MFMA(U1, f11, c1);
            f32x16 c0 = SBA_MFMA(U0, f00, Dv); c0 = SBA_MFMA(U1, f01, c0);
            C = SBA_MFMA(J, f00, Dv); C = SBA_MFMA(J, f01, C);
#pragma unroll
            for (int r = 0; r < 16; ++r) { z0[r] = __builtin_amdgcn_exp2f(z0[r] - c0[r]); z1[r] = __builtin_amdgcn_exp2f(z1[r] - c1[r]); }
            const bf16x8 p0 = pack8(z0, 0), p1 = pack8(z0, 8), p2 = pack8(z1, 0), p3 = pack8(z1, 8);
            pv(o, vb0 + slot, p0, p1, p2, p3);
            if (__all(C[0] >= CARRY_ZERO)) { wdone = true; if (lane == 0) flg[wid] = i; }
        }
        SBA_WAIT_BAR();
        { int m = flg[0];
#pragma unroll
          for (int w = 1; w < 8; ++w) { const int f = flg[w]; m = f > m ? f : m; }
          if (__builtin_amdgcn_readfirstlane(m) <= i) break; }
    }
    { unsigned short* stg = (unsigned short*)(shm + LDS_OST) + wid * 2048;
#pragma unroll
      for (int r = 0; r < 16; ++r) { const int orow = crow(r, hi);
#pragma unroll
          for (int d0 = 0; d0 < 2; ++d0) stg[orow * 64 + d0 * 32 + r32] = (unsigned short)(cvtpk_s(o[d0][r], 0.f) & 0xffffu); }
      asm volatile("s_waitcnt lgkmcnt(0)" ::: "memory");
      const __amdgpu_buffer_rsrc_t rmix = __builtin_amdgcn_make_buffer_rsrc((void*)MIX, (short)0, (int)(16384u * 1024u * 2u), 0x00020000);
#pragma unroll
      for (int i = 0; i < 4; ++i) { const int row = i * 8 + (lane >> 3), ch = lane & 7; const u32x4 v = *(const u32x4*)(stg + row * 64 + ch * 8); __builtin_amdgcn_raw_buffer_store_b128(v, rmix, (int)(((rowbase + q0 + wid * 32 + row) * D + MIXOFF + h * 64 + ch * 8) * 2), 0, 16); } }
    asm volatile("s_waitcnt lgkmcnt(0)\n\ts_barrier" ::: "memory");
#undef SBA_DMA
}
}

constexpr int NWAVES = 8;
#ifndef MK_N_LAUNCHES
#define MK_N_LAUNCHES 1
#endif
constexpr int N_PHASES = 12;
constexpr size_t MiB = 1u << 20;
constexpr size_t WS_CTL = 0, CTL_ZERO_BYTES = 64 * 1024;
constexpr int CW_BAR = 4096;
constexpr size_t WS_SSPA = 1 * MiB, WS_SSPB = WS_SSPA + 256 * 1024, WS_BO = WS_SSPB + 256 * 1024;
constexpr size_t WS_WIN = 2 * MiB, WS_WOUT = 11 * MiB, WS_WUP = 15 * MiB, WS_WDN = 37 * MiB;
constexpr size_t WS_XB = 48 * MiB;
constexpr size_t WS_R = 81 * MiB, WS_PROJ = WS_R, WS_MIX = WS_R + 72 * MiB, WS_H = WS_R, WS_END = WS_R + 104 * MiB;
static_assert(WS_XB + (size_t)(M + 256) * D * 2 <= WS_R && WS_END <= 256 * MiB && WS_H + (size_t)M * DFF * 2 <= WS_END && WS_MIX + (size_t)M * D * 2 <= WS_END, "ws map");
constexpr int RING_OFF = 0, RING_BYTES = 131072, XL_OFF = RING_BYTES, LDSCTL_OFF = XL_OFF + 4096, MISC_OFF = LDSCTL_OFF + 320, LDS_BYTES = 147456;

struct Frame { LAS unsigned char* lds; volatile LAS unsigned* MISC; gu32* ctl; int tid, lane, wave, vcu, G; };
__device__ __forceinline__ float wave_sum(float v) { return pg8::wave_sum_all(v); }
__device__ __forceinline__ float bf2f(unsigned short b) { return __builtin_bit_cast(float, (unsigned)b << 16); }
__device__ __forceinline__ int map_in(int n) { const int t = n >> 8, j = n & 255; return (t < 2) ? ((j < 128) ? 128 * t + j : 256 + 128 * t + (j - 128)) : n; }
__device__ __forceinline__ int map_up(int n) { const int t = n >> 8, j = n & 255; return (j < 128) ? 128 * t + j : DFF + 128 * t + (j - 128); }

__device__ __forceinline__ void p0_transpose_item(const float* W, int K, int N, const float* g, bf16* WT, int src0, int n0, int k0, LAS float* scr, int lane, float cs = 1.0f) {
    f32x4 wv[16];
#pragma unroll
    for (int i = 0; i < 16; ++i) wv[i] = *(const f32x4*)(W + (size_t)(k0 + 4 * i + (lane >> 4)) * N + src0 + 4 * (lane & 15));
    float gv[16];
    if (g) {
#pragma unroll
        for (int i = 0; i < 16; ++i) gv[i] = g[k0 + 4 * i + (lane >> 4)];
    } else {
#pragma unroll
        for (int i = 0; i < 16; ++i) gv[i] = 1.0f; }
#pragma unroll
    for (int i = 0; i < 16; ++i) { const int kk = 4 * i + (lane >> 4); const float sc = gv[i] * cs; LAS float* d = scr + kk * 65 + 4 * (lane & 15);
        d[0] = wv[i].x * sc; d[1] = wv[i].y * sc; d[2] = wv[i].z * sc; d[3] = wv[i].w * sc; }
    LDS_WAIT(); asm volatile("" ::: "memory");
    const int c = lane & 7;
#pragma unroll
    for (int j = 0; j < 8; ++j) { const int n = (lane >> 3) + 8 * j; const LAS float* s = scr + (8 * c) * 65 + n;
        v4u o; o.x = pk2(s[0 * 65], s[1 * 65]); o.y = pk2(s[2 * 65], s[3 * 65]); o.z = pk2(s[4 * 65], s[5 * 65]); o.w = pk2(s[6 * 65], s[7 * 65]);
        *(v4u*)(WT + (size_t)(n0 + n) * K + k0 + 8 * c) = o; }
    LDS_WAIT(); asm volatile("" ::: "memory");
}
struct Ptrs {
    const float *x, *norm1_g, *w_in, *cdw_w, *cdw_b, *cln_g, *cln_b, *cpw_w, *cpw_b, *pool_w, *pool_scale, *w_out, *norm2_g, *ffn_up, *fdw_w, *fdw_b, *ffn_down, *final_g;
    float* out; float *SSPA, *SSPB, *BO; bf16 *WIN, *WOUT, *WUP, *WDN, *XB, *PROJ, *MIX, *H;
};
constexpr unsigned PREP_ALL = 0x1ffu;
#ifndef PREP_DEFER
#define PREP_DEFER 0
#endif
__device__ __forceinline__ void prep(Frame& F, const Ptrs& P, unsigned mask, int rank, int nranks) {
    LAS float* scr = (LAS float*)(F.lds + RING_OFF + F.wave * 16640);
    const int lane = F.lane;
    constexpr int I_IN = 16 * 36, I_UP = 16 * 88, I_DN = 44 * 16;
    int cnt[2][7]; int total = 0;
#pragma unroll
    for (int l = 0; l < 2; ++l) { cnt[l][0] = (mask & (1u << l)) ? I_IN : 0; cnt[l][1] = (mask & (4u << l)) ? I_UP : 0; cnt[l][2] = (mask & (16u << l)) ? I_DN : 0;
        const int f = (mask & (64u << l)) ? 1024 : 0; cnt[l][3] = 0; cnt[l][4] = f; cnt[l][5] = f; cnt[l][6] = f ? 16 : 0;
#pragma unroll
        for (int c = 0; c < 7; ++c) total += cnt[l][c]; }
    { const int nA = ((mask & 64u) ? 1024 : 0) + ((mask & 128u) ? 1024 : 0);
#pragma nounroll
      for (int it = rank; it < nA; it += nranks) {
        const int l = (mask & 64u) ? it / 1024 : 1, r = it % 1024;
        const int kg = r / 16, nt = r % 16, k0 = 4 * kg, n = 64 * nt + lane;
        const float* wo = P.w_out + (size_t)l * D * D + n; const float* pw = P.cpw_w + (size_t)l * DCONV * DCONV + (size_t)k0 * DCONV; float acc[4] = {0.f, 0.f, 0.f, 0.f};
#pragma nounroll
        for (int j0 = 0; j0 < 256; j0 += 64) { float wv[64];
#pragma unroll
            for (int u = 0; u < 64; ++u) wv[u] = wo[(size_t)(j0 + u) * D];
#pragma unroll
            for (int u = 0; u < 64; ++u)
#pragma unroll
                for (int i = 0; i < 4; ++i) acc[i] += pw[i * DCONV + j0 + u] * wv[u]; }
        *(unsigned long long*)(P.WOUT + (size_t)l * D * D + (size_t)n * D + k0) = (unsigned long long)pk2(acc[0], acc[1]) | ((unsigned long long)pk2(acc[2], acc[3]) << 32); } }
#pragma nounroll
    for (int it0 = rank; it0 < total; it0 += nranks) {
        int r = it0, l = 0, cls = 0;
#pragma unroll
        for (int ll = 0; ll < 2; ++ll)
#pragma unroll
            for (int c = 0; c < 7; ++c) { const bool in_ = (cls < 8) && (r < cnt[ll][c]); if (in_) { l = ll; cls = c + 8; } if (cls < 8) r -= cnt[ll][c]; }
        cls -= 8;
        if (cls == 0) { const int kb = r / 36, nb = r % 36;
            p0_transpose_item(P.w_in + (size_t)l * D * DIN, D, DIN, P.norm1_g + l * D, P.WIN + (size_t)l * DIN * D, map_in(64 * nb), 64 * nb, 64 * kb, scr, lane, (64 * nb >= 768 && 64 * nb < 1280) ? 0.125f * 1.4426950408889634f : 1.0f); }
        else if (cls == 1) { const int kb = r / 88, nb = r % 88;
            p0_transpose_item(P.ffn_up + (size_t)l * D * DUP, D, DUP, P.norm2_g + l * D, P.WUP + (size_t)l * DUP * D, map_up(64 * nb), 64 * nb, 64 * kb, scr, lane); }
        else if (cls == 2) { const int kb = r / 16, nb = r % 16;
            p0_transpose_item(P.ffn_down + (size_t)l * DFF * D, DFF, D, nullptr, P.WDN + (size_t)l * D * DFF, 64 * nb, 64 * nb, 64 * kb, scr, lane); }
        else if (cls == 4) {
            const int kg = r / 16, nt = r % 16, k0 = 256 + 4 * kg, n = 64 * nt + lane;
            const int g = (k0 - 256) >> 6, c0 = (k0 - 256) & 63; const float* pw = P.pool_w + (size_t)l * 4 * 64 * 64 + (size_t)(g * 64 + c0) * 64; const float* ps = P.pool_scale + l * DPOOL + 64 * g;
            const float* wo = P.w_out + (size_t)l * D * D + (size_t)(256 + 64 * g) * D + n; float acc[4] = {0.f, 0.f, 0.f, 0.f};
            for (int d0 = 0; d0 < 64; d0 += 8) { float wv[8];
#pragma unroll
                for (int u = 0; u < 8; ++u) wv[u] = ps[d0 + u] * wo[(size_t)(d0 + u) * D];
#pragma unroll
                for (int u = 0; u < 8; ++u)
#pragma unroll
                    for (int i = 0; i < 4; ++i) acc[i] += pw[i * 64 + d0 + u] * wv[u]; }
            *(unsigned long long*)(P.WOUT + (size_t)l * D * D + (size_t)n * D + k0) = (unsigned long long)pk2(acc[0], acc[1]) | ((unsigned long long)pk2(acc[2], acc[3]) << 32); }
        else if (cls == 5) {
            const int kg = r / 16, nt = r % 16, k0 = 512 + 8 * kg, n = 64 * nt + lane;
            const float* wo = P.w_out + (size_t)l * D * D + n; float acc[8];
#pragma unroll
            for (int i = 0; i < 8; ++i) acc[i] = wo[(size_t)(k0 + i) * D];
            v4u o; o.x = pk2(acc[0], acc[1]); o.y = pk2(acc[2], acc[3]); o.z = pk2(acc[4], acc[5]); o.w = pk2(acc[6], acc[7]);
            *(v4u*)(P.WOUT + (size_t)l * D * D + (size_t)n * D + k0) = o; }
        else { const int n = 64 * r + lane; float acc = 0.f;
            for (int j = 0; j < 256; ++j) acc += P.cpw_b[l * DCONV + j] * P.w_out[(size_t)l * D * D + (size_t)j * D + n];
            P.BO[l * D + n] = acc; }
    }
    if (mask & 256u) for (int r0 = 4 * rank; r0 < M; r0 += 4 * nranks) {
        f32x4 v[4][4];
#pragma unroll
        for (int q = 0; q < 4; ++q)
#pragma unroll
            for (int j = 0; j < 4; ++j) v[q][j] = ((const f32x4*)(P.x + (size_t)(r0 + q) * D) + lane)[64 * j];
#pragma unroll
        for (int q = 0; q < 4; ++q) { float s = 0.f; unsigned long long* o = (unsigned long long*)(P.XB + (size_t)(r0 + q) * D) + lane;
#pragma unroll
            for (int j = 0; j < 4; ++j) { const f32x4 t = v[q][j]; s += (t.x * t.x + t.y * t.y) + (t.z * t.z + t.w * t.w); o[64 * j] = (unsigned long long)pk2(t.x, t.y) | ((unsigned long long)pk2(t.z, t.w) << 32); }
            s = wave_sum(s); if (lane == 0) *(f32x4*)(P.SSPB + (size_t)(r0 + q) * 4) = (f32x4){s, 0.f, 0.f, 0.f}; }
    }
}
__device__ __forceinline__ void convpool_unit(Frame& F, const Ptrs& P, int l, int t0) {
    bf16* Ul = (bf16*)(F.lds + RING_OFF); float* Y = (float*)(F.lds + RING_OFF + 94 * 256 * 2);
    LAS bf16* UlL = (LAS bf16*)(F.lds + RING_OFF); LAS float* YL = (LAS float*)(F.lds + RING_OFF + 94 * 256 * 2); (void)Ul; (void)Y;
    const int tid = F.tid, tl = t0 % SEQ; const bf16* PR = P.PROJ;
    { v4u av[6], gv[6];
#pragma unroll
      for (int k = 0; k < 6; ++k) { const int i = tid + 512 * k; const int r = i >> 5, ch = i & 31, c0 = ch * 8, tt = c0 >> 7, j = c0 & 127; const int tok = tl - 30 + r;
          const int rr = (r > 93 ? 93 : r), rowc = (tok >= 0) ? (t0 - 30 + rr) : t0;
          const bf16* rp = PR + (size_t)rowc * DIN + 256 * tt + j; av[k] = *(const v4u*)rp; gv[k] = *(const v4u*)(rp + 128);
          if (tok < 0) { av[k] = (v4u){0u, 0u, 0u, 0u}; gv[k] = av[k]; } }
#pragma unroll
      for (int k = 0; k < 6; ++k) { const int i = tid + 512 * k; const int r = i >> 5, ch = i & 31, c0 = ch * 8; unsigned ov[4];
#pragma unroll
          for (int q = 0; q < 4; ++q) { const unsigned aw = av[k][q], gw_ = gv[k][q];
              const float a0 = bf2f((unsigned short)(aw & 0xffff)), a1 = bf2f((unsigned short)(aw >> 16)), g0 = bf2f((unsigned short)(gw_ & 0xffff)), g1 = bf2f((unsigned short)(gw_ >> 16));
              ov[q] = pk2(a0 / (1.0f + __expf(-g0)), a1 / (1.0f + __expf(-g1))); }
          if (i < 94 * 32) *(LAS v4u*)(UlL + r * 256 + c0) = (v4u){ov[0], ov[1], ov[2], ov[3]}; } }
    __syncthreads();
    const int c = tid & 255, half = tid >> 8;
    const int tb = tl + half * 32; const bf16* pc = PR + 512 + c; unsigned short pv_[47];
#pragma unroll
    for (int k = 0; k < 47; ++k) { const int tok = tb - 15 + k; pv_[k] = pc[(size_t)(t0 + half * 32 + (tok >= 0 ? k - 15 : 0)) * DIN]; }
#pragma unroll
    for (int k = 0; k < 15; ++k) if (tb - 15 + k < 0) pv_[k] = (unsigned short)0;
    { const float* dw_w = P.cdw_w + (size_t)l * CONVK * DCONV; float w[CONVK];
#pragma unroll
      for (int i = 0; i < CONVK; ++i) w[i] = dw_w[i * DCONV + c];
      const float bb = P.cdw_b[l * DCONV + c];
#pragma unroll 1
      for (int g = 0; g < 2; ++g) { const int tbq = half * 32 + g * 16; float in[46];
#pragma unroll
          for (int i = 0; i < 46; ++i) in[i] = bf2f(UlL[(tbq + i) * 256 + c]);
#pragma unroll
          for (int q = 0; q < 16; ++q) { float acc = bb;
#pragma unroll
              for (int i = 0; i < CONVK; ++i) acc += w[i] * in[q + i];
              YL[(tbq + q) * 256 + c] = acc; } } }
    __syncthreads();
    { const int wv = F.wave, lane = F.lane; const f32x4 gg = ((const f32x4*)(P.cln_g + l * DCONV))[lane], bbv = ((const f32x4*)(P.cln_b + l * DCONV))[lane];
      f32x4 y[8]; float s1[8], s2[8];
#pragma unroll
      for (int q = 0; q < 8; ++q) { y[q] = ((const LAS f32x4*)(YL + (wv * 8 + q) * 256))[lane]; s1[q] = (y[q].x + y[q].y) + (y[q].z + y[q].w); }
#pragma unroll
      for (int q = 0; q < 8; ++q) s1[q] += pg8::swz_xor<1>(s1[q]);
#pragma unroll
      for (int q = 0; q < 8; ++q) s1[q] += pg8::swz_xor<2>(s1[q]);
#pragma unroll
      for (int q = 0; q < 8; ++q) s1[q] += pg8::swz_xor<4>(s1[q]);
#pragma unroll
      for (int q = 0; q < 8; ++q) s1[q] += pg8::swz_xor<8>(s1[q]);
#pragma unroll
      for (int q = 0; q < 8; ++q) s1[q] += pg8::swz_xor<16>(s1[q]);
#pragma unroll
      for (int q = 0; q < 8; ++q) { const float mu = pg8::add_xor32(s1[q]) * (1.0f / 256.0f); y[q] = y[q] - mu; s2[q] = (y[q].x * y[q].x + y[q].y * y[q].y) + (y[q].z * y[q].z + y[q].w * y[q].w); }
#pragma unroll
      for (int q = 0; q < 8; ++q) s2[q] += pg8::swz_xor<1>(s2[q]);
#pragma unroll
      for (int q = 0; q < 8; ++q) s2[q] += pg8::swz_xor<2>(s2[q]);
#pragma unroll
      for (int q = 0; q < 8; ++q) s2[q] += pg8::swz_xor<4>(s2[q]);
#pragma unroll
      for (int q = 0; q < 8; ++q) s2[q] += pg8::swz_xor<8>(s2[q]);
#pragma unroll
      for (int q = 0; q < 8; ++q) s2[q] += pg8::swz_xor<16>(s2[q]);
#pragma unroll
      for (int q = 0; q < 8; ++q) { const float rs = 1.0f / sqrtf(pg8::add_xor32(s2[q]) * (1.0f / 256.0f) + EPS);
          f32x4 z = y[q] * rs * gg + bbv; z.x = z.x / (1.0f + __expf(-z.x)); z.y = z.y / (1.0f + __expf(-z.y)); z.z = z.z / (1.0f + __expf(-z.z)); z.w = z.w / (1.0f + __expf(-z.w));
          *(unsigned long long*)(P.MIX + (size_t)(t0 + wv * 8 + q) * D + 4 * lane) = (unsigned long long)pk2(z.x, z.y) | ((unsigned long long)pk2(z.z, z.w) << 32); } }
    { const int win = 2 << (c >> 6);
#pragma unroll
      for (int q = 0; q < 32; ++q) { float s = 0.f;
#pragma unroll
          for (int j = 0; j < 16; ++j) s += (j < win) ? bf2f(pv_[15 + q - j]) : 0.f;
          const int tloc = tb + q; const int cnt = (tloc + 1 < win) ? tloc + 1 : win;
          P.MIX[(size_t)(t0 + half * 32 + q) * D + 256 + c] = (bf16)f2bf(s / (float)cnt - bf2f(pv_[15 + q])); } }
    __syncthreads();
}
__device__ __forceinline__ void mixers_phase(Frame& F, const Ptrs& P, int l) {
#ifdef DBG_MIX_T
    volatile LAS unsigned long long* TSm = (volatile LAS unsigned long long*)(F.lds + MISC_OFF + 256); if (blockIdx.x == 0 && F.tid == 0) TSm[38] = rt();
#endif
    for (int u = F.vcu; u < M / 64; u += F.G) convpool_unit(F, P, l, 64 * u);
#ifdef DBG_MIX_T
    if (blockIdx.x == 0 && F.tid == 0) { const unsigned long long t1 = rt(); TSm[36] += t1 - TSm[38]; TSm[38] = t1; }
#endif
    for (int k = 0; k < 2; ++k) for (int c = F.vcu; c < 256; c += F.G) { const int bh = c >> 2, j = c & 3, qb = k ? 7 - j : j;
        sba::attn_unit(bh >> 3, bh & 7, qb, P.PROJ, P.MIX, (char*)F.lds + RING_OFF, F.wave, F.lane); }
#ifdef DBG_MIX_T
    if (blockIdx.x == 0 && F.tid == 0) { TSm[37] += rt() - TSm[38]; }
#endif
}
__device__ __forceinline__ void final_phase(Frame& F, const Ptrs& P) {
    const int gw = F.vcu * NWAVES + F.wave, NGW = F.G * NWAVES, lane = F.lane;
    for (int r0 = 2 * gw; r0 < M; r0 += 2 * NGW) {
        v4u xb[2][2]; float r[2];
#pragma unroll
        for (int q = 0; q < 2; ++q) { xb[q][0] = ((const v4u*)(P.XB + (size_t)(r0 + q) * D))[lane]; xb[q][1] = ((const v4u*)(P.XB + (size_t)(r0 + q) * D))[64 + lane]; r[q] = pg8::rs_from_ssp(P.SSPB, r0 + q); }
#pragma unroll
        for (int q = 0; q < 2; ++q)
#pragma unroll
            for (int hf = 0; hf < 2; ++hf) { const f32x4* gr = (const f32x4*)(P.final_g + 512 * hf + 8 * lane); f32x4* o = (f32x4*)(P.out + (size_t)(r0 + q) * D + 512 * hf + 8 * lane); const v4u w = xb[q][hf];
                f32x4 a, b2; a[0] = __builtin_bit_cast(float, w[0] << 16); a[1] = __builtin_bit_cast(float, w[0] & 0xffff0000u); a[2] = __builtin_bit_cast(float, w[1] << 16); a[3] = __builtin_bit_cast(float, w[1] & 0xffff0000u);
                b2[0] = __builtin_bit_cast(float, w[2] << 16); b2[1] = __builtin_bit_cast(float, w[2] & 0xffff0000u); b2[2] = __builtin_bit_cast(float, w[3] << 16); b2[3] = __builtin_bit_cast(float, w[3] & 0xffff0000u);
                o[0] = a * r[q] * gr[0]; o[1] = b2 * r[q] * gr[1]; }
    }
}

#define MKP() Ptrs P; do { unsigned char* ws = args.ws; asm volatile("" : "+s"(ws)); P.x = args.in[0]; P.norm1_g = args.in[1]; P.w_in = args.in[2]; P.cdw_w = args.in[3]; P.cdw_b = args.in[4]; P.cln_g = args.in[5]; P.cln_b = args.in[6]; P.cpw_w = args.in[7]; P.cpw_b = args.in[8]; P.pool_w = args.in[9]; P.pool_scale = args.in[10]; P.w_out = args.in[11]; P.norm2_g = args.in[12]; P.ffn_up = args.in[13]; P.fdw_w = args.in[14]; P.fdw_b = args.in[15]; P.ffn_down = args.in[16]; P.final_g = args.in[17]; P.out = args.out; P.SSPA = (float*)(ws + WS_SSPA); P.SSPB = (float*)(ws + WS_SSPB); P.BO = (float*)(ws + WS_BO); P.WIN = (bf16*)(ws + WS_WIN); P.WOUT = (bf16*)(ws + WS_WOUT); P.WUP = (bf16*)(ws + WS_WUP); P.WDN = (bf16*)(ws + WS_WDN); P.XB = (bf16*)(ws + WS_XB); P.PROJ = (bf16*)(ws + WS_PROJ); P.MIX = (bf16*)(ws + WS_MIX); P.H = (bf16*)(ws + WS_H); } while (0)
struct Args { const float* in[18]; float* out; unsigned char* ws; int ph_lo, ph_hi; };
__global__ void __launch_bounds__(NWAVES * 64, 2) mega_fwd(Args args) {
    extern __shared__ __attribute__((aligned(16))) unsigned char lds[];
    Frame F;
    F.lds = (LAS unsigned char*)lds; F.MISC = (volatile LAS unsigned*)(F.lds + MISC_OFF);
    F.tid = threadIdx.x; F.lane = F.tid & 63; F.wave = __builtin_amdgcn_readfirstlane(F.tid >> 6);
    F.G = gridDim.x; { const int bx = blockIdx.x; F.vcu = (F.G % 8 == 0) ? (bx % 8) * (F.G / 8) + bx / 8 : bx; }
    F.ctl = (gu32*)(args.ws + WS_CTL);
    for (int u = F.tid; u < (LDS_BYTES - LDSCTL_OFF) / 4; u += NWAVES * 64) ((LAS unsigned*)(F.lds + LDSCTL_OFF))[u] = 0u;
    __syncthreads();
    const int lo = args.ph_lo, hi = args.ph_hi;
    const bool use_bar = (hi - lo) > 1;
    XcdBarrier bar; bar.bar = (unsigned*)(F.ctl + CW_BAR); bar.x = 0; bar.st = nullptr;
    if (use_bar) bar = xcd_barrier_post((unsigned*)(F.ctl + CW_BAR), F.MISC + 8);
#define REFRESH() do { int l_; asm volatile("v_mbcnt_lo_u32_b32 %0, -1, 0\n\tv_mbcnt_hi_u32_b32 %0, -1, %0" : "=v"(l_)); F.lane = l_; F.tid = 64 * F.wave + l_; } while (0)
#define LAUNDER_S(v) asm volatile("" : "+s"(v))
#ifdef DBG_TIMING
#ifndef DBG_GT_ST
#define DBG_GT_ST 3
#endif
    volatile LAS unsigned long long* TS = (volatile LAS unsigned long long*)(F.lds + MISC_OFF + 256);
    const bool stamper = (blockIdx.x == 0 && threadIdx.x == 0);
    if (stamper) { TS[0] = rt(); TS[16] = 0; TS[32] = 0; TS[33] = 0; TS[34] = 0; TS[35] = 0; TS[36] = 0; TS[37] = 0; }
#endif
#pragma nounroll
    for (int ph_ = lo; ph_ < hi; ++ph_) {
        int ph = ph_; LAUNDER_S(ph);
        const int l = (ph - 1) / 5, st = (ph == 0) ? -1 : (ph == N_PHASES - 1 ? 5 : (ph - 1) % 5);
        int bx = (int)blockIdx.x; LAUNDER_S(bx);
        MKP();
        if (st == -1) { }
        else if (st == 0) {
            pg8::Gemm g{P.XB, P.WIN + (size_t)l * DIN * D, M, DIN, D}; pg8::StaticOrder S; S.init(M, DIN, F.G, bx);
            pg8::EpiProj E{P.PROJ, DIN, P.SSPB};
            pg8::gemm_phase<pg8::EpiProj, pg8::StaticOrder, PG8_ALIGN, PG8_SP2>(F.lds + RING_OFF, g, S, E, F.wave); }
        else if (st == 1) { REFRESH(); mixers_phase(F, P, l); }
        else if (st == 2 || st == 4) {
            const bool o = (st == 2);
            pg8::Gemm g{o ? P.MIX : P.H, o ? P.WOUT + (size_t)l * D * D : P.WDN + (size_t)l * D * DFF, M, D, o ? D : DFF}; pg8::StaticOrder S; S.init(M, D, F.G, bx);
            pg8::EpiRes E{P.XB, o ? P.BO + l * D : nullptr, o ? P.SSPA : P.SSPB};
            pg8::gemm_phase<pg8::EpiRes, pg8::StaticOrder, false, PG8_SP2>(F.lds + RING_OFF, g, S, E, F.wave); }
        else if (st == 3) {
            pg8::Gemm g{P.XB, P.WUP + (size_t)l * DUP * D, M + 256, DUP, D}; pg8::StaticOrder S; S.init(M + 256, DUP, F.G, bx);
            pg8::EpiUp E{P.H, P.SSPA, P.fdw_w + (size_t)l * 3 * DFF, P.fdw_b + (size_t)l * DFF, (LAS float*)(F.lds + XL_OFF)};
            pg8::gemm_phase<pg8::EpiUp, pg8::StaticOrder, true, PG8_SP2>(F.lds + RING_OFF, g, S, E, F.wave); }
        else { REFRESH(); final_phase(F, P); }
#ifdef DBG_TIMING
        unsigned long long tb0 = 0; if (stamper) tb0 = rt();
#endif
        {
            unsigned pm_ = 0u; int rk_ = 0, nr_ = 1;
            if (F.G != 256 || !PREP_DEFER) { if (st == -1) { pm_ = PREP_ALL; rk_ = F.vcu * NWAVES + F.wave; nr_ = F.G * NWAVES; } }
            else if (st == -1) { pm_ = 0x101u; rk_ = F.vcu * NWAVES + F.wave; nr_ = 256 * NWAVES; }
            else if (st == 0 && l == 0 && bx >= 64) { pm_ = 0x54u; rk_ = (bx - 64) * NWAVES + F.wave; nr_ = 192 * NWAVES; }
            else if (st == 3 && l == 0 && bx >= 150) { pm_ = 0x82u; rk_ = (bx - 150) * NWAVES + F.wave; nr_ = 106 * NWAVES; }
            else if (st == 0 && l == 1 && bx >= 64) { pm_ = 0x28u; rk_ = (bx - 64) * NWAVES + F.wave; nr_ = 192 * NWAVES; }
            if (pm_) { REFRESH(); prep(F, P, pm_, rk_, nr_); }
        }
        if (ph_ + 1 < hi) xcd_barrier(bar);
#ifdef DBG_TIMING
        if (stamper) { TS[ph_ + 1] = rt(); TS[16] += TS[ph_ + 1] - tb0;
            if (st == DBG_GT_ST) { TS[34] = TS[32]; TS[35] = TS[33]; } else { TS[32] = TS[34]; TS[33] = TS[35]; } }
#endif
    }
#ifdef DBG_TIMING
    if (stamper) { asm volatile("s_waitcnt vmcnt(0) lgkmcnt(0)" ::: "memory");
        float g[8];
        auto dd = [&](int k) { return (float)(TS[k + 1] - TS[k]) * 0.01f; };
        g[0] = dd(0); g[1] = dd(1) + dd(6); g[2] = dd(2) + dd(7); g[3] = dd(3) + dd(8); g[4] = dd(4) + dd(9); g[5] = dd(5) + dd(10); g[6] = dd(11); g[7] = (float)(TS[12] - TS[0]) * 0.01f;
        float g8 = (float)TS[16] * 0.01f, g9 = (float)TS[32] * 0.01f, g10 = (float)TS[33] * 0.01f;
#ifdef DBG_MIX_T
        g9 = (float)TS[36] * 0.01f; g10 = (float)TS[37] * 0.01f;
#endif (void)g8; (void)g9; (void)g10;
        args.out[0] = 0.25f * (DBG_SEL0 < 8 ? g[DBG_SEL0 & 7] : (DBG_SEL0 == 8 ? g8 : (DBG_SEL0 == 9 ? g9 : g10))); args.out[1] = 0.25f * (DBG_SEL1 < 8 ? g[DBG_SEL1 & 7] : (DBG_SEL1 == 8 ? g8 : (DBG_SEL1 == 9 ? g9 : g10))); }
#endif
}

extern "C" void kernel_launch(void* const* d_in, const int* in_sizes, int n_in, void* d_out, int out_size, void* d_ws, size_t ws_size, hipStream_t stream) {
    static int grid = 0;
    if (grid == 0) {
        if (n_in != 18 || in_sizes[0] != M * D || out_size != M * D || ws_size < WS_END) { fprintf(stderr, "kernel_launch: unexpected shapes (n_in %d, ws %zu)\n", n_in, ws_size); grid = -1; return; }
        int dev = 0, cus = 0, per_cu = 0;
        if (hipGetDevice(&dev) != hipSuccess || hipDeviceGetAttribute(&cus, hipDeviceAttributeMultiprocessorCount, dev) != hipSuccess) { grid = -1; return; }
        if (hipFuncSetAttribute((const void*)mega_fwd, hipFuncAttributeMaxDynamicSharedMemorySize, LDS_BYTES) != hipSuccess) { fprintf(stderr, "kernel_launch: hipFuncSetAttribute failed\n"); grid = -1; return; }
        if (hipOccupancyMaxActiveBlocksPerMultiprocessor(&per_cu, (const void*)mega_fwd, NWAVES * 64, LDS_BYTES) != hipSuccess || per_cu < 1) { fprintf(stderr, "kernel_launch: occupancy query says %d blocks per CU\n", per_cu); }
        (void)hipGetLastError();
        grid = cus;
        if (grid != 256) fprintf(stderr, "kernel_launch: %d CUs (the fused epilogues assume 256)\n", grid);
    }
    if (grid < 0) return;
    (void)hipMemsetAsync((char*)d_ws + WS_CTL, 0, CTL_ZERO_BYTES, stream);
    Args a{};
    for (int i = 0; i < 18; ++i) a.in[i] = (const float*)d_in[i];
    a.out = (float*)d_out; a.ws = (unsigned char*)d_ws;
    if (MK_N_LAUNCHES == 1) { a.ph_lo = 0; a.ph_hi = N_PHASES; hipLaunchKernelGGL(mega_fwd, dim3(grid), dim3(NWAVES * 64), LDS_BYTES, stream, a); }
    else for (int p = 0; p < N_PHASES; ++p) { a.ph_lo = p; a.ph_hi = p + 1; hipLaunchKernelGGL(mega_fwd, dim3(grid), dim3(NWAVES * 64), LDS_BYTES, stream, a); }
}
```

```cpp
#include <hip/hip_runtime.h>
#include <cstdio>
#include <cstdint>
constexpr int D = 1024, BATCH = 8, SEQ = 2048, DEPTH = 2, M = BATCH * SEQ;
constexpr int DCONV = 256, DPOOL = 256, DATT = 512, NH = 8, HD = 64, CONVK = 31, DFF = 2816, DIN = 2304, DUP = 2 * DFF;
constexpr float EPS = 1e-6f;
namespace pg8 {
#define PG8_LAS __attribute__((address_space(3)))
typedef unsigned short bf16_t;
typedef short bf16x8 __attribute__((ext_vector_type(8)));
typedef float f32x4 __attribute__((ext_vector_type(4)));
typedef unsigned u32x4 __attribute__((ext_vector_type(4)));
constexpr int BM = 256, BK = 64, HALF = 128, HTB = HALF * BK * 2  , STAGE_BYTES = 8 * HTB, NXCD = 8, WGM = 8;

__host__ __device__ __forceinline__ int lds_byte(int r, int c) { const int st = (r >> 4) * 2 + (c >> 5), rr = r & 15, cc = c & 31, ob = rr * 64 + cc * 2; return st * 1024 + (ob ^ (((ob >> 9) & 1) << 5)); }
__host__ __device__ __forceinline__ void stage_rc(int b, int& R, int& C) { const int st = b / 1024, sb = b % 1024, swz = sb ^ (((sb >> 9) & 1) << 5); R = (st >> 1) * 16 + swz / 64; C = (st & 1) * 32 + (swz % 64) / 2; }
__host__ __device__ __forceinline__ int perm32(int rho) { const int n = rho >> 4, i = rho & 15; return 8 * (i >> 2) + 4 * n + (i & 3); }

struct Unit { int pm, pn; };
struct Gemm { const bf16_t* A; const bf16_t* Bt; int M, N, K; };

struct StaticOrder {
    int nM, nN, nwg, G, c;
    __host__ __device__ void init(int M, int N, int G_, int c_) { nM = M / BM; nN = N / BM; nwg = nM * nN; G = G_; c = c_; }
    __host__ __device__ bool next(int i, Unit& u) const {
        const long L = (long)i * G + c; if (L >= nwg) return false;
        int wgid = (int)L; { const int q = nwg / NXCD, r = nwg % NXCD, xcd = wgid % NXCD, off = wgid / NXCD; wgid = (xcd < r ? xcd * (q + 1) : r * (q + 1) + (xcd - r) * q) + off; }
        const int nig = WGM * nN, gid = wgid / nig, fm = gid * WGM, gsz = (nM - fm) < WGM ? (nM - fm) : WGM;
        u.pm = fm + ((wgid % nig) % gsz); u.pn = (wgid % nig) / gsz; return true;
    }
    __device__ __forceinline__ void a_ready(const Unit&) const {}
    __device__ __forceinline__ void done(const Unit&) const {}
};

__device__ __forceinline__ unsigned cvt_pk_bf16(float lo, float hi) { unsigned r; asm volatile("v_cvt_pk_bf16_f32 %0, %1, %2" : "=v"(r) : "v"(lo), "v"(hi)); return r; }
typedef float f32x2 __attribute__((ext_vector_type(2)));
__device__ __forceinline__ f32x2 gelu_pk(f32x2 v) {
    const f32x2 av = __builtin_elementwise_abs(v), d = av * 0.2316418882f + 1.0f;
    f32x2 t; t.x = __builtin_amdgcn_rcpf(d.x); t.y = __builtin_amdgcn_rcpf(d.y);
    f32x2 q = t * 0.5307027145f + (-0.7265760135f); q = q * t + 0.7107068705f; q = q * t + (-0.142248368f); q = q * t + 0.127414796f; q = q * t;
    const f32x2 s = (v * v) * (-0.72134752044f);
    f32x2 e; e.x = __builtin_amdgcn_exp2f(s.x); e.y = __builtin_amdgcn_exp2f(s.y);
    const f32x2 m = v * (q * e), r = v - m;
    f32x2 o; o.x = v.x < 0.f ? m.x : r.x; o.y = v.y < 0.f ? m.y : r.y; return o;
}
template <int X> __device__ __forceinline__ float swz_xor(float v) { return __builtin_bit_cast(float, __builtin_amdgcn_ds_swizzle(__builtin_bit_cast(int, v), (X << 10) | 0x1f)); }
__device__ __forceinline__ float add_xor32(float v) { float a = v, b = v; asm volatile("s_nop 1\n\tv_permlane32_swap_b32 %0, %1" : "+v"(a), "+v"(b)); return a + b; }
__device__ __forceinline__ float wave_sum_all(float v) { v += swz_xor<1>(v); v += swz_xor<2>(v); v += swz_xor<4>(v); v += swz_xor<8>(v); v += swz_xor<16>(v); return add_xor32(v); }
__device__ __forceinline__ float rs_from_s4(const f32x4 s) { return __builtin_amdgcn_rsqf(((s[0] + s[1]) + (s[2] + s[3])) * (1.0f / 1024.0f) + 1e-6f); }
__device__ __forceinline__ float rs_from_ssp(const float* ssp, int R) { return rs_from_s4(*(const f32x4*)(ssp + (size_t)R * 4)); }
template <int CTRL> __device__ __forceinline__ float dppf(float old, float src) { return __builtin_bit_cast(float, __builtin_amdgcn_update_dpp(__builtin_bit_cast(int, old), __builtin_bit_cast(int, src), CTRL, 0xf, 0xf, false)); }
constexpr int DPP_SHR1 = 0x111, DPP_SHR2 = 0x112, DPP_ROR1 = 0x121, DPP_ROR2 = 0x122;

__device__ __forceinline__ int lane_id_now() { int l; asm volatile("v_mbcnt_lo_u32_b32 %0, -1, 0\n\tv_mbcnt_hi_u32_b32 %0, -1, %0" : "=v"(l)); return l; }
typedef __amdgpu_buffer_rsrc_t rsrc_t;
__device__ __forceinline__ rsrc_t make_rsrc(void* p, unsigned bytes) { return __builtin_amdgcn_make_buffer_rsrc(p, (short)0, (int)bytes, 0x00020000); }
__device__ __forceinline__ void st16_wt(rsrc_t r, unsigned byte_off, u32x4 v) { __builtin_amdgcn_raw_buffer_store_b128(v, r, (int)byte_off, 0, 16); }
struct EpiProj {
    static constexpr bool PERM = true, AFTER_DRAIN = false;
    bf16_t* O; int ldc; const float* ssp;
    __device__ __forceinline__ void operator()(const f32x4 (&acc)[2][2][4][2], const Unit& u, int wr, int wc, int fr, int fq) const {
        { const int l_ = lane_id_now(); fr = l_ & 15; fq = l_ >> 4; }
        const int row0 = u.pm * BM + wr * 64 + fr, col0 = u.pn * BM + wc * 32 + 8 * fq; const rsrc_t ro = make_rsrc(O, 16384u * 2304u * 2u);
        f32x4 s4[2][4];
#pragma unroll
        for (int ai = 0; ai < 2; ++ai)
#pragma unroll
            for (int m = 0; m < 4; ++m) s4[ai][m] = *(const f32x4*)(ssp + (size_t)(row0 + ai * HALF + m * 16) * 4);
#pragma unroll
        for (int ai = 0; ai < 2; ++ai)
#pragma unroll
            for (int m = 0; m < 4; ++m) { const int R = row0 + ai * HALF + m * 16; const float sc = rs_from_s4(s4[ai][m]); const unsigned rowb = ((unsigned)R * (unsigned)ldc + (unsigned)col0) * 2u;
#pragma unroll
                for (int bj = 0; bj < 2; ++bj) { const f32x4 v0 = acc[ai][bj][m][0] * sc, v1 = acc[ai][bj][m][1] * sc;
                    u32x4 w; w.x = cvt_pk_bf16(v0[0], v0[1]); w.y = cvt_pk_bf16(v0[2], v0[3]); w.z = cvt_pk_bf16(v1[0], v1[1]); w.w = cvt_pk_bf16(v1[2], v1[3]);
                    st16_wt(ro, rowb + bj * HALF * 2, w); } }
    }
};
struct EpiUp {
    static constexpr bool PERM = true, AFTER_DRAIN = false;
    bf16_t* H; const float* ssp; const float* dww; const float* dwb; PG8_LAS float* xl;
    __device__ __forceinline__ void operator()(f32x4 (&acc)[2][2][4][2], const Unit& u, int wr, int wc, int fr, int fq) const {
        { const int l_ = lane_id_now(); fr = l_ & 15; fq = l_ >> 4; asm volatile("" : "+s"(wr), "+s"(wc)); }
        const bool halo = (u.pm == 64); const rsrc_t rh = make_rsrc(H, 16384u * 2816u * 2u);
        const int ch0 = u.pn * HALF + wc * 32 + 8 * fq;
        f32x4 s4[2][4];
#pragma unroll
        for (int ai = 0; ai < 2; ++ai)
#pragma unroll
            for (int m = 0; m < 4; ++m) { const int rt = ai * HALF + wr * 64 + m * 16 + fr; int R = halo ? 256 * (rt >> 2) - 2 + (rt & 3) : u.pm * BM + rt; R = R < 0 ? 0 : R; s4[ai][m] = *(const f32x4*)(ssp + (size_t)R * 4); }
#pragma unroll
        for (int ai = 0; ai < 2; ++ai)
#pragma unroll
            for (int m = 0; m < 4; ++m) {
                const float sc = rs_from_s4(s4[ai][m]);
#pragma unroll
                for (int bj = 0; bj < 2; ++bj)
#pragma unroll
                    for (int n = 0; n < 2; ++n) acc[ai][bj][m][n] *= sc; }
        if (fr >= 14) {
#pragma unroll
            for (int ai = 0; ai < 2; ++ai)
#pragma unroll
                for (int n = 0; n < 2; ++n) *(PG8_LAS f32x4*)(xl + ((ai * 2 + wr) * 4 + wc) * 64 + (fr - 14) * 32 + fq * 8 + n * 4) = acc[ai][1][3][n]; }
        asm volatile("s_waitcnt lgkmcnt(0)" ::: "memory"); __builtin_amdgcn_s_barrier(); asm volatile("" ::: "memory");
        f32x4 w0[2], w1[2], w2[2], bb[2];
#pragma unroll
        for (int n = 0; n < 2; ++n) { w0[n] = *(const f32x4*)(dww + ch0 + 4 * n); w1[n] = *(const f32x4*)(dww + DFF + ch0 + 4 * n); w2[n] = *(const f32x4*)(dww + 2 * DFF + ch0 + 4 * n); bb[n] = *(const f32x4*)(dwb + ch0 + 4 * n); }
#pragma unroll
        for (int ai = 0; ai < 2; ++ai)
#pragma unroll
            for (int m = 0; m < 4; ++m) {
                f32x4 prev[2];
                if (m > 0) { prev[0] = acc[ai][1][m - 1][0]; prev[1] = acc[ai][1][m - 1][1]; }
                else { prev[0] = (f32x4){0.f, 0.f, 0.f, 0.f}; prev[1] = prev[0];
                    const int sai = wr ? ai : ai - 1, swr = wr ? 0 : 1;
                    if (!halo && sai >= 0 && fr >= 14) {
#pragma unroll
                        for (int n = 0; n < 2; ++n) prev[n] = *(const PG8_LAS f32x4*)(xl + ((sai * 2 + swr) * 4 + wc) * 64 + (fr - 14) * 32 + fq * 8 + n * 4); } }
                f32x4 hv[2];
#pragma unroll
                for (int n = 0; n < 2; ++n) { const f32x4 cur = acc[ai][1][m][n]; f32x4 g1, g2;
#pragma unroll
                    for (int i = 0; i < 4; ++i) { const float p1 = halo ? 0.f : dppf<DPP_ROR1>(0.f, prev[n][i]), p2 = halo ? 0.f : dppf<DPP_ROR2>(0.f, prev[n][i]);
                        g1[i] = dppf<DPP_SHR1>(p1, cur[i]); g2[i] = dppf<DPP_SHR2>(p2, cur[i]); }
                    const f32x4 gc = w0[n] * g2 + w1[n] * g1 + w2[n] * cur + bb[n];
                    const f32x2 ga = gelu_pk((f32x2){gc[0], gc[1]}), gb = gelu_pk((f32x2){gc[2], gc[3]});
                    hv[n] = acc[ai][0][m][n] * (f32x4){ga.x, ga.y, gb.x, gb.y}; }
                const int rt = ai * HALF + wr * 64 + m * 16 + fr;
                u32x4 w; w.x = cvt_pk_bf16(hv[0][0], hv[0][1]); w.y = cvt_pk_bf16(hv[0][2], hv[0][3]); w.z = cvt_pk_bf16(hv[1][0], hv[1][1]); w.w = cvt_pk_bf16(hv[1][2], hv[1][3]);
                if (!halo) { if (!(rt < 2 && (u.pm & 7) != 0)) st16_wt(rh, ((unsigned)(u.pm * BM + rt) * (unsigned)DFF + (unsigned)ch0) * 2u, w); }
                else { const int k = rt >> 2, j = rt & 3; if (j >= 2 && (k & 7) != 0) st16_wt(rh, ((unsigned)(256 * k + j - 2) * (unsigned)DFF + (unsigned)ch0) * 2u, w); }
            }
    }
};
struct EpiRes {
    static constexpr bool PERM = true, AFTER_DRAIN = true;
    bf16_t* XB; const float* bias; float* sspo;
    __device__ __forceinline__ void fused(f32x4 (&acc)[2][2][4][2], const Unit& u, int wr, int wc, int fr, int fq, PG8_LAS unsigned char* lds, int wid, int lane) const {
        PG8_LAS float* P = (PG8_LAS float*)lds;
        { const int l_ = lane_id_now(); fr = l_ & 15; fq = l_ >> 4; lane = l_; }
        const int col0 = u.pn * BM + wc * 32 + 8 * fq; const rsrc_t rx = make_rsrc(XB, (16384u + 256u) * 1024u * 2u);
        f32x4 bv[2][2];
#pragma unroll
        for (int bj = 0; bj < 2; ++bj)
#pragma unroll
            for (int n = 0; n < 2; ++n) bv[bj][n] = bias ? *(const f32x4*)(bias + col0 + bj * HALF + 4 * n) : (f32x4){0.f, 0.f, 0.f, 0.f};
        u32x4 xin[2][4][2];
#pragma unroll
        for (int ai = 0; ai < 2; ++ai)
#pragma unroll
            for (int m = 0; m < 4; ++m)
#pragma unroll
                for (int bj = 0; bj < 2; ++bj) xin[ai][m][bj] = __builtin_amdgcn_raw_buffer_load_b128(rx, (int)(((unsigned)(u.pm * BM + ai * HALF + wr * 64 + m * 16 + fr) * 1024u + (unsigned)col0) * 2u + bj * HALF * 2), 0, 0);
#pragma unroll
        for (int ai = 0; ai < 2; ++ai)
#pragma unroll
            for (int m = 0; m < 4; ++m) { const int rt = ai * HALF + wr * 64 + m * 16 + fr, R = u.pm * BM + rt; const unsigned off = ((unsigned)R * 1024u + (unsigned)col0) * 2u; float s = 0.f;
                int hr = -1; if (rt < 2) hr = 16384 + 4 * u.pm + 2 + rt; else if (rt >= 254) hr = 16384 + 4 * (u.pm + 1) + (rt - 254);
#pragma unroll
                for (int bj = 0; bj < 2; ++bj) { const u32x4 xb = xin[ai][m][bj];
                    f32x4 x0, x1;
                    x0[0] = __builtin_bit_cast(float, xb[0] << 16); x0[1] = __builtin_bit_cast(float, xb[0] & 0xffff0000u); x0[2] = __builtin_bit_cast(float, xb[1] << 16); x0[3] = __builtin_bit_cast(float, xb[1] & 0xffff0000u);
                    x1[0] = __builtin_bit_cast(float, xb[2] << 16); x1[1] = __builtin_bit_cast(float, xb[2] & 0xffff0000u); x1[2] = __builtin_bit_cast(float, xb[3] << 16); x1[3] = __builtin_bit_cast(float, xb[3] & 0xffff0000u);
                    x0 = x0 + acc[ai][bj][m][0] + bv[bj][0]; x1 = x1 + acc[ai][bj][m][1] + bv[bj][1];
                    s += ((x0[0] * x0[0] + x0[1] * x0[1]) + (x0[2] * x0[2] + x0[3] * x0[3])) + ((x1[0] * x1[0] + x1[1] * x1[1]) + (x1[2] * x1[2] + x1[3] * x1[3]));
                    u32x4 w; w.x = cvt_pk_bf16(x0[0], x0[1]); w.y = cvt_pk_bf16(x0[2], x0[3]); w.z = cvt_pk_bf16(x1[0], x1[1]); w.w = cvt_pk_bf16(x1[2], x1[3]);
                    st16_wt(rx, off + bj * HALF * 2, w);
                    if (hr >= 0 && hr < 16384 + 256) st16_wt(rx, ((unsigned)hr * 1024u + (unsigned)col0) * 2u + bj * HALF * 2, w); }
                s += swz_xor<16>(s); s = add_xor32(s);
                if (fq == 0) P[rt * 4 + wc] = s; }
        asm volatile("s_waitcnt lgkmcnt(0)" ::: "memory"); __builtin_amdgcn_s_barrier(); asm volatile("" ::: "memory");
        const int tid = wid * 64 + lane;
        if (tid < 256) { const f32x4 p = *(const PG8_LAS f32x4*)(P + tid * 4); sspo[(size_t)(u.pm * BM + tid) * 4 + u.pn] = (p[0] + p[1]) + (p[2] + p[3]); }
        asm volatile("s_waitcnt lgkmcnt(0)" ::: "memory"); __builtin_amdgcn_s_barrier(); asm volatile("" ::: "memory");
    }
};
template <class Epi, class Sched, bool ALIGN_EPI = false, bool SP2 = false>
__device__ __forceinline__ void gemm_phase(PG8_LAS unsigned char* lds, const Gemm g, const Sched& S, const Epi& E, int wave_id  ) {
    int tid_; asm volatile("v_mbcnt_lo_u32_b32 %0, -1, 0\n\tv_mbcnt_hi_u32_b32 %0, -1, %0" : "=v"(tid_)); tid_ += 64 * wave_id;
    const int tid = tid_, wid = __builtin_amdgcn_readfirstlane(tid >> 6), lane = tid & 63, wr = wid >> 2, wc = wid & 3, fr = lane & 15, fq = lane >> 4;
    const int K = g.K, nt = K / BK;
    unsigned voffA[2], voffB[2];
#pragma unroll
    for (int i = 0; i < 2; ++i) { int R, C; stage_rc(tid * 16 + i * 8192, R, C); const int Rb = Epi::PERM ? ((R & ~31) + perm32(R & 31)) : R;
        voffA[i] = (unsigned)(R * K + C) * 2u; voffB[i] = (unsigned)(Rb * K + C) * 2u; }
    const size_t kstep = (size_t)(BK * 2);
    const size_t hstep = (size_t)HALF * K * 2;
    const size_t tstep = 2 * hstep;
    const unsigned ldsw = (unsigned)wid * 1024u;
    const int aoff = lds_byte(wr * 64 + fr, fq * 8), boff = lds_byte(wc * 32 + fr, fq * 8);
#define PG8_SA(b, h) (((b) * 2 + (h)) * HTB)
#define PG8_SB(b, h) ((4 + (b) * 2 + (h)) * HTB)
#define PG8_STAGE(bufoff, gbase, voff) do { _Pragma("unroll") for (int _i = 0; _i < 2; ++_i) \
        __builtin_amdgcn_global_load_lds((const unsigned*)((const char*)(gbase) + (voff)[_i]), (PG8_LAS unsigned*)(lds + (bufoff) + ldsw + _i * 8192), 16, 0, 0); } while (0)
#define PG8_LDA(dst, b, h) do { _Pragma("unroll") for (int m = 0; m < 4; ++m) _Pragma("unroll") for (int k = 0; k < 2; ++k) dst[m][k] = *(const PG8_LAS bf16x8*)(lds + PG8_SA(b, h) + aoff + m * 2048 + k * 1024); } while (0)
#define PG8_LDB(dst, b, h) do { _Pragma("unroll") for (int n = 0; n < 2; ++n) _Pragma("unroll") for (int k = 0; k < 2; ++k) dst[n][k] = *(const PG8_LAS bf16x8*)(lds + PG8_SB(b, h) + boff + n * 2048 + k * 1024); } while (0)
#define PG8_MMA(ai, bj, At, Bt) do { __builtin_amdgcn_s_setprio(1); _Pragma("unroll") for (int m = 0; m < 4; ++m) _Pragma("unroll") for (int n = 0; n < 2; ++n) _Pragma("unroll") for (int k = 0; k < 2; ++k) \
        acc[ai][bj][m][n] = __builtin_amdgcn_mfma_f32_16x16x32_bf16(Bt[n][k], At[m][k], acc[ai][bj][m][n], 0, 0, 0); __builtin_amdgcn_s_setprio(0); } while (0)
#define PG8_WAIT_V(n) asm volatile("s_waitcnt vmcnt(" #n ")" ::: "memory")
#define PG8_WAIT_L(n) asm volatile("s_waitcnt lgkmcnt(" #n ")" ::: "memory")
#define PG8_BAR __builtin_amdgcn_s_barrier()
#define PG8_SCHED __builtin_amdgcn_sched_barrier(0)
    Unit cur, nxt; int ui = 0;
    if (!S.next(0, cur)) return;
    f32x4 acc[2][2][4][2];
#pragma unroll
    for (int a = 0; a < 2; ++a)
#pragma unroll
        for (int b = 0; b < 2; ++b)
#pragma unroll
            for (int m = 0; m < 4; ++m)
#pragma unroll
                for (int n = 0; n < 2; ++n) acc[a][b][m][n] = (f32x4){0.f, 0.f, 0.f, 0.f};
    bf16x8 At[4][2], B0[2][2], B1[2][2];
    const char* cA = (const char*)g.A + (size_t)cur.pm * tstep; const char* cB = (const char*)g.Bt + (size_t)cur.pn * tstep;
    S.a_ready(cur);
    if constexpr (SP2) {
        PG8_STAGE(PG8_SB(0, 0), cB, voffB); PG8_STAGE(PG8_SB(0, 1), cB + hstep, voffB); PG8_STAGE(PG8_SA(0, 0), cA, voffA); PG8_STAGE(PG8_SA(0, 1), cA + hstep, voffA);
        if (wr == 1) PG8_BAR;
        PG8_WAIT_V(2); PG8_BAR;
        PG8_STAGE(PG8_SB(1, 0), cB + kstep, voffB); PG8_STAGE(PG8_SA(1, 0), cA + kstep, voffA); PG8_STAGE(PG8_SB(1, 1), cB + hstep + kstep, voffB);
        PG8_WAIT_V(6); PG8_BAR;
    } else {
        PG8_STAGE(PG8_SB(0, 0), cB, voffB); PG8_STAGE(PG8_SA(0, 0), cA, voffA); PG8_STAGE(PG8_SB(0, 1), cB + hstep, voffB); PG8_STAGE(PG8_SA(0, 1), cA + hstep, voffA);
        if (wr == 1) PG8_BAR;
        PG8_WAIT_V(4); PG8_BAR;
        PG8_STAGE(PG8_SB(1, 0), cB + kstep, voffB); PG8_STAGE(PG8_SA(1, 0), cA + kstep, voffA); PG8_STAGE(PG8_SB(1, 1), cB + hstep + kstep, voffB);
        PG8_WAIT_V(6); PG8_BAR;
    }
#ifdef DBG_GEMM_T
    volatile PG8_LAS unsigned long long* GT = (volatile PG8_LAS unsigned long long*)(lds + 135488 + 512); const bool gt_on = (blockIdx.x == 0 && tid == 0); unsigned long long gt0 = 0;
#endif
    for (;;) {
#ifdef DBG_GEMM_T
        if (gt_on) gt0 = __builtin_amdgcn_s_memrealtime();
#endif
        const bool has_next = S.next(ui + 1, nxt);
        const char* nA = has_next ? (const char*)g.A + (size_t)nxt.pm * tstep : cA; const char* nB = has_next ? (const char*)g.Bt + (size_t)nxt.pn * tstep : cB;
        for (int t = 0; t < nt; t += 2) {
            const bool last = (t == nt - 2);
            const char* a1 = cA + (size_t)(t + 1) * kstep;
            const char* a2 = last ? nA : cA + (size_t)(t + 2) * kstep; const char* b2 = last ? nB : cB + (size_t)(t + 2) * kstep;
            const char* a3 = a2 + kstep; const char* b3 = b2 + kstep;
            if (last && has_next) S.a_ready(nxt);
            if constexpr (SP2) {
            PG8_LDB(B0, 0, 0); PG8_LDB(B1, 0, 1); PG8_SCHED; PG8_LDA(At, 0, 0); PG8_STAGE(PG8_SA(1, 1), a1 + hstep, voffA);
            PG8_WAIT_V(8); PG8_WAIT_L(0); PG8_BAR; PG8_MMA(0, 0, At, B0); PG8_MMA(0, 1, At, B1); PG8_BAR; PG8_SCHED;
            PG8_LDA(At, 0, 1); PG8_STAGE(PG8_SB(0, 0), b2, voffB); PG8_STAGE(PG8_SB(0, 1), b2 + hstep, voffB); PG8_STAGE(PG8_SA(0, 0), a2, voffA);
            PG8_WAIT_V(8); PG8_WAIT_L(0); PG8_BAR; PG8_MMA(1, 0, At, B0); PG8_MMA(1, 1, At, B1); PG8_BAR; PG8_SCHED;
            PG8_LDB(B0, 1, 0); PG8_LDB(B1, 1, 1); PG8_SCHED; PG8_LDA(At, 1, 0); PG8_STAGE(PG8_SA(0, 1), a2 + hstep, voffA);
            PG8_WAIT_V(8); PG8_WAIT_L(0); PG8_BAR; PG8_MMA(0, 0, At, B0); PG8_MMA(0, 1, At, B1); PG8_BAR; PG8_SCHED;
            PG8_LDA(At, 1, 1); PG8_STAGE(PG8_SB(1, 0), b3, voffB); PG8_STAGE(PG8_SB(1, 1), b3 + hstep, voffB); PG8_STAGE(PG8_SA(1, 0), a3, voffA);
            PG8_WAIT_V(8); PG8_WAIT_L(0); PG8_BAR; PG8_MMA(1, 0, At, B0); PG8_MMA(1, 1, At, B1); PG8_BAR; PG8_SCHED;
            } else {
            PG8_LDB(B0, 0, 0); PG8_SCHED; PG8_LDA(At, 0, 0); PG8_STAGE(PG8_SA(1, 1), a1 + hstep, voffA);
            PG8_WAIT_L(8); PG8_BAR; PG8_WAIT_L(0); PG8_MMA(0, 0, At, B0); PG8_BAR; PG8_SCHED;
            PG8_LDB(B1, 0, 1); PG8_STAGE(PG8_SB(0, 0), b2, voffB);
            PG8_BAR; PG8_WAIT_L(0); PG8_MMA(0, 1, At, B1); PG8_BAR;
            PG8_LDA(At, 0, 1); PG8_STAGE(PG8_SA(0, 0), a2, voffA);
            PG8_BAR; PG8_WAIT_L(0); PG8_MMA(1, 0, At, B0); PG8_BAR; PG8_SCHED;
            PG8_STAGE(PG8_SB(0, 1), b2 + hstep, voffB);
            PG8_WAIT_V(6); PG8_BAR; PG8_MMA(1, 1, At, B1); PG8_BAR;
            PG8_LDB(B0, 1, 0); PG8_SCHED; PG8_LDA(At, 1, 0); PG8_STAGE(PG8_SA(0, 1), a2 + hstep, voffA);
            PG8_WAIT_L(8); PG8_BAR; PG8_WAIT_L(0); PG8_MMA(0, 0, At, B0); PG8_BAR; PG8_SCHED;
            PG8_LDB(B1, 1, 1); PG8_STAGE(PG8_SB(1, 0), b3, voffB);
            PG8_BAR; PG8_WAIT_L(0); PG8_MMA(0, 1, At, B1); PG8_BAR;
            PG8_LDA(At, 1, 1); PG8_STAGE(PG8_SA(1, 0), a3, voffA);
            PG8_BAR; PG8_WAIT_L(0); PG8_MMA(1, 0, At, B0); PG8_BAR; PG8_SCHED;
            PG8_STAGE(PG8_SB(1, 1), b3 + hstep, voffB);
            PG8_WAIT_V(6); PG8_BAR; PG8_MMA(1, 1, At, B1); PG8_BAR;
            }
        }
        if constexpr (ALIGN_EPI) { if (wr == 0) PG8_BAR; }
#ifdef DBG_GEMM_T
        if (gt_on) { const unsigned long long t1 = __builtin_amdgcn_s_memrealtime(); GT[0] += t1 - gt0; gt0 = t1; }
#endif
        if constexpr (!Epi::AFTER_DRAIN) { E(acc, cur, wr, wc, fr, fq); S.done(cur); }
#ifdef DBG_GEMM_T
        if (gt_on) { const unsigned long long t1 = __builtin_amdgcn_s_memrealtime(); GT[1] += t1 - gt0; }
#endif
        if (!has_next) break;
#pragma unroll
        for (int a = 0; a < 2; ++a)
#pragma unroll
            for (int b = 0; b < 2; ++b)
#pragma unroll
                for (int m = 0; m < 4; ++m)
#pragma unroll
                    for (int n = 0; n < 2; ++n) acc[a][b][m][n] = (f32x4){0.f, 0.f, 0.f, 0.f};
        cur = nxt; cA = nA; cB = nB; ++ui;
        if constexpr (ALIGN_EPI) { if (wr == 1) PG8_BAR; }
    }
    PG8_WAIT_V(0);
    if constexpr (!ALIGN_EPI) { if (wr == 0) PG8_BAR; }
    PG8_BAR;
    if constexpr (Epi::AFTER_DRAIN) { E.fused(acc, cur, wr, wc, fr, fq, lds, wid, lane); S.done(cur); }
#undef PG8_SA
#undef PG8_SB
#undef PG8_STAGE
#undef PG8_LDA
#undef PG8_LDB
#undef PG8_MMA
#undef PG8_WAIT_V
#undef PG8_WAIT_L
#undef PG8_BAR
#undef PG8_SCHED
}
}

#ifndef PG8_SP2
#define PG8_SP2 true
#endif
#ifndef PG8_ALIGN
#define PG8_ALIGN true
#endif
#define GAS __attribute__((address_space(1)))
#define LAS __attribute__((address_space(3)))
typedef unsigned short bf16;
typedef unsigned v4u __attribute__((ext_vector_type(4)));
typedef float f32x4 __attribute__((ext_vector_type(4)));
typedef short bf16x8 __attribute__((ext_vector_type(8)));
typedef GAS unsigned gu32;
typedef GAS unsigned long long gu64;
#define RLX_AGENT __ATOMIC_RELAXED, __HIP_MEMORY_SCOPE_AGENT
#define LDS_WAIT() asm volatile("s_waitcnt lgkmcnt(0)" ::: "memory")
#define VM_WAIT() asm volatile("s_waitcnt vmcnt(0)" ::: "memory")
__device__ __forceinline__ unsigned long long rt() { return __builtin_amdgcn_s_memrealtime(); }
__device__ __forceinline__ unsigned f2bf(float f) { unsigned u = __builtin_bit_cast(unsigned, f); return (u + 0x7fffu + ((u >> 16) & 1u)) >> 16; }
__device__ __forceinline__ unsigned pk2(float lo, float hi) { return f2bf(lo) | (f2bf(hi) << 16); }

#define XB_TMO      128
#define XB_XCNT(j)  (256  + 64 * (j))
#define XB_XSUB(j)  (1280 + 64 * (j))
#define XB_XGEN(j)  (2304 + 64 * (j))
#define XB_TOP      3328
#define XB_TOPGEN   3392
#define XCD_BAR_WORDS 3456
#define XB_SPIN_CAP (1u << 18)

__device__ __forceinline__ unsigned xb_ld(unsigned* p)              { return __hip_atomic_load(p, __ATOMIC_RELAXED, __HIP_MEMORY_SCOPE_AGENT); }
__device__ __forceinline__ unsigned xb_add(unsigned* p, unsigned v) { return __hip_atomic_fetch_add(p, v, __ATOMIC_RELAXED, __HIP_MEMORY_SCOPE_AGENT); }
__device__ __forceinline__ unsigned xb_xcc_id() { return (unsigned)__builtin_amdgcn_s_getreg((3 << 11) | 20) & 0xFu; }
#define XB_SPIN(cond, bar) do { unsigned _sp = 0; while (cond) { __builtin_amdgcn_s_sleep(1); \
    if ((++_sp & 255u) == 0u) { if (xb_ld(&(bar)[XB_TMO])) break; if (_sp > XB_SPIN_CAP) { atomicAdd(&(bar)[XB_TMO], 1u); break; } } } } while (0)

struct XcdBarrier {
    unsigned* bar; unsigned x;
    volatile LAS unsigned* st;
};

__device__ __forceinline__ XcdBarrier xcd_barrier_post(unsigned* bar, volatile LAS unsigned* st) {
    XcdBarrier b; b.bar = bar; b.x = xb_xcc_id(); b.st = st;
    if (threadIdx.x == 0) (void)xb_add(&bar[XB_XCNT(b.x)], 1u);
    return b;
}
__device__ __forceinline__ void xcd_barrier_complete(unsigned* bar, unsigned x, unsigned& nloc, unsigned& nx) {
    const unsigned G = gridDim.x * gridDim.y * gridDim.z;
    unsigned sum, cnt, mine, sp = 0u;
    for (;;) {
        sum = 0u; cnt = 0u; mine = 0u;
#pragma unroll
        for (unsigned j = 0; j < 16; ++j) { const unsigned c = xb_ld(&bar[XB_XCNT(j)]); sum += c; cnt += (c > 0u) ? 1u : 0u; }
        mine = xb_ld(&bar[XB_XCNT(x)]);
        if (sum == G) break;
        __builtin_amdgcn_s_sleep(1);
        if ((++sp & 255u) == 0u) { if (xb_ld(&bar[XB_TMO])) break; if (sp > XB_SPIN_CAP) { atomicAdd(&bar[XB_TMO], 1u); break; } }
    }
    nloc = mine > 0u ? mine : 1u; nx = cnt > 0u ? cnt : 1u;
}

__device__ __forceinline__ void xcd_barrier(const XcdBarrier& b) {
    asm volatile("s_waitcnt vmcnt(0)" ::: "memory");
    __syncthreads();
    if (threadIdx.x == 0) {
        unsigned* bar = b.bar;
        __builtin_amdgcn_s_waitcnt(0);
        unsigned nloc = b.st[0], nx = b.st[1];
        if (nloc == 0u) { xcd_barrier_complete(bar, b.x, nloc, nx); b.st[0] = nloc; b.st[1] = nx; }
        const unsigned old = xb_add(&bar[XB_XSUB(b.x)], 1u);
        const unsigned gen = old / nloc;
        if (old + 1u == (gen + 1u) * nloc) {
            __builtin_amdgcn_fence(__ATOMIC_RELEASE, "agent");
            asm volatile("s_waitcnt vmcnt(0)" ::: "memory");
            const unsigned og = xb_add(&bar[XB_TOP], 1u);
            const unsigned tg = og / nx;
            if (og + 1u == (tg + 1u) * nx) xb_add(&bar[XB_TOPGEN], 1u);
            else XB_SPIN(xb_ld(&bar[XB_TOPGEN]) == tg, bar);
            __builtin_amdgcn_fence(__ATOMIC_ACQUIRE, "agent");
            xb_add(&bar[XB_XGEN(b.x)], 1u);
            asm volatile("s_waitcnt vmcnt(0)" ::: "memory");
        } else {
            XB_SPIN(xb_ld(&bar[XB_XGEN(b.x)]) == gen, bar);
            __builtin_amdgcn_fence(__ATOMIC_ACQUIRE, "agent");
            asm volatile("s_waitcnt vmcnt(0)" ::: "memory");
        }
    }
    __syncthreads();
}

namespace sba {
typedef short bf16x8 __attribute__((ext_vector_type(8)));
typedef short s16x4 __attribute__((ext_vector_type(4)));
typedef float f32x16 __attribute__((ext_vector_type(16)));
typedef unsigned u32x4 __attribute__((ext_vector_type(4)));
constexpr int PITCH = DIN, QOFF = 768, KOFF = 1280, VOFF = 1792, MIXOFF = 512;
constexpr int SLOTB = 8192, LDS_K = 0, LDS_V = 2 * SLOTB, LDS_OST = 4 * SLOTB, LDS_FLG = LDS_OST + 8 * 4096, LDS_BYTES_ATT = LDS_FLG + 64;
constexpr float CARRY_ZERO = 152.0f;
__device__ __forceinline__ int crow(int r, int hi) { return (r & 3) + 8 * (r >> 2) + 4 * hi; }
__device__ __forceinline__ void glds16(const void* gsrc, unsigned lds_dst) { unsigned keep;
    asm volatile("s_mov_b32 %0, m0\n\ts_mov_b32 m0, %2\n\ts_nop 0\n\tglobal_load_lds_dwordx4 %1, off\n\ts_mov_b32 m0, %0" : "=&s"(keep) : "v"(gsrc), "s"(lds_dst) : "memory"); }
typedef float f32x2_t __attribute__((ext_vector_type(2))); typedef __bf16 bf16x2_t __attribute__((ext_vector_type(2)));
__device__ __forceinline__ unsigned cvtpk_s(float lo, float hi) { f32x2_t v = {lo, hi}; bf16x2_t b = __builtin_convertvector(v, bf16x2_t); return __builtin_bit_cast(unsigned, b); }
#define SBA_WAIT_BAR() asm volatile("s_waitcnt vmcnt(0) lgkmcnt(0)\n\ts_barrier" ::: "memory")
#define SBA_SBAR() __builtin_amdgcn_sched_barrier(0)
typedef __attribute__((address_space(3))) const char* lds_cptr;
__device__ __forceinline__ void kload8(bf16x8* kf, lds_cptr kp) {
    kf[0] = *(const __attribute__((address_space(3))) bf16x8*)(kp);        kf[1] = *(const __attribute__((address_space(3))) bf16x8*)(kp + 512);
    kf[2] = *(const __attribute__((address_space(3))) bf16x8*)(kp + 2048); kf[3] = *(const __attribute__((address_space(3))) bf16x8*)(kp + 2560);
    kf[4] = *(const __attribute__((address_space(3))) bf16x8*)(kp + 4096); kf[5] = *(const __attribute__((address_space(3))) bf16x8*)(kp + 4608);
    kf[6] = *(const __attribute__((address_space(3))) bf16x8*)(kp + 6144); kf[7] = *(const __attribute__((address_space(3))) bf16x8*)(kp + 6656);
}
#define SBA_MFMA(a, b, c) __builtin_amdgcn_mfma_f32_32x32x16_bf16((a), (b), (c), 0, 0, 0)
__device__ __forceinline__ void pv(f32x16* o, int vb, bf16x8 pa0, bf16x8 pa1, bf16x8 pa2, bf16x8 pa3) {
#pragma unroll
    for (int d0 = 0; d0 < 2; ++d0) { s16x4 lo[4], hi[4];
#pragma unroll
        for (int ks = 0; ks < 4; ++ks) {
            asm volatile("ds_read_b64_tr_b16 %0,%1 offset:%c2" : "=&v"(lo[ks]) : "v"(vb), "i"(d0 * 4096 + ks * 1024) : "memory");
            asm volatile("ds_read_b64_tr_b16 %0,%1 offset:%c2" : "=&v"(hi[ks]) : "v"(vb), "i"(d0 * 4096 + ks * 1024 + 512) : "memory"); }
        asm volatile("s_waitcnt lgkmcnt(0)" ::: "memory"); SBA_SBAR();
#define SBA_PK(k) (bf16x8){lo[k][0], lo[k][1], lo[k][2], lo[k][3], hi[k][0], hi[k][1], hi[k][2], hi[k][3]}
        o[d0] = SBA_MFMA(pa0, SBA_PK(0), o[d0]); o[d0] = SBA_MFMA(pa1, SBA_PK(1), o[d0]); o[d0] = SBA_MFMA(pa2, SBA_PK(2), o[d0]); o[d0] = SBA_MFMA(pa3, SBA_PK(3), o[d0]);
#undef SBA_PK
    }
}
__device__ __forceinline__ bf16x8 pack8(const f32x16& x, int b) { u32x4 p; p[0] = cvtpk_s(x[b], x[b + 1]); p[1] = cvtpk_s(x[b + 2], x[b + 3]); p[2] = cvtpk_s(x[b + 4], x[b + 5]); p[3] = cvtpk_s(x[b + 6], x[b + 7]); return __builtin_bit_cast(bf16x8, p); }

__device__ __forceinline__ void attn_unit(int b, int h, int qb, const unsigned short* PROJ, unsigned short* MIX, char* shm, int wid, int lane) {
    const int r32 = lane & 31, hi = lane >> 5;
    const long rowbase = (long)b * SEQ; const int q0 = qb * 256;
    const unsigned short* Qw = PROJ + (rowbase + q0 + wid * 32) * PITCH + QOFF + h * 64;
    const unsigned short* Kh = PROJ + rowbase * PITCH + KOFF + h * 64; const unsigned short* Vh = PROJ + rowbase * PITCH + VOFF + h * 64;
    const unsigned lds0 = (unsigned)(uintptr_t)shm;
    const unsigned short* ksrc = Kh + (long)lane * PITCH + wid * 8;
    const unsigned short* vsrc = Vh + (long)(16 * (wid & 3) + (lane >> 2)) * PITCH + (wid >> 2) * 32 + (lane & 3) * 8;
    const unsigned kdst = lds0 + LDS_K + wid * 1024, vdst = lds0 + LDS_V + wid * 1024;
#define SBA_DMA(t, slot) do { glds16(ksrc + (long)(t) * 64 * PITCH, (unsigned)__builtin_amdgcn_readfirstlane(kdst + (slot))); glds16(vsrc + (long)(t) * 64 * PITCH, (unsigned)__builtin_amdgcn_readfirstlane(vdst + (slot))); } while (0)
    const int vb0 = (int)(lds0 + LDS_V) + ((lane >> 4) & 1) * 32 + (lane & 3) * 8 + (4 * hi + ((lane & 15) >> 2)) * 64;
    const lds_cptr kp0 = (lds_cptr)shm + LDS_K + hi * 1024 + r32 * 16;
    const int NT = 4 * (qb + 1);
    SBA_DMA(NT - 1, 0);
    bf16x8 qr[4];
#pragma unroll
    for (int d0 = 0; d0 < 4; ++d0) qr[d0] = *reinterpret_cast<const bf16x8*>(&Qw[(long)r32 * PITCH + d0 * 16 + hi * 8]);
    bf16x8 U0, U1, J;
#pragma unroll
    for (int j = 0; j < 8; ++j) { const int k0 = 8 * (j >> 2) + 4 * hi + (j & 3); U0[j] = (k0 >= r32) ? (short)0x3F80 : (short)0; U1[j] = (16 + k0 >= r32) ? (short)0x3F80 : (short)0; J[j] = (short)0x3F80; }
    f32x16 C, o[2];
#pragma unroll
    for (int r = 0; r < 16; ++r) { C[r] = 0.f; o[0][r] = 0.f; o[1][r] = 0.f; }
    const int qrel = wid * 32 + r32;
    volatile __attribute__((address_space(3))) int* flg = (volatile __attribute__((address_space(3))) int*)((lds_cptr)shm + LDS_FLG);
    if (lane == 0) flg[wid] = 0x7fffffff;
    bool wdone = false;
    SBA_WAIT_BAR();
    for (int i = 0; i < NT; ++i) {
        const int t = NT - 1 - i, slot = (i & 1) * SLOTB, jb = t - 4 * qb;
        if (i + 1 < NT) SBA_DMA(t - 1, slot ^ SLOTB);
        if (!wdone && !(jb >= 0 && 2 * jb > wid)) {
            bf16x8 kf[8]; kload8(kf, kp0 + slot);
            f32x16 z0, z1;
#pragma unroll
            for (int r = 0; r < 16; ++r) { z0[r] = 0.f; z1[r] = 0.f; }
#pragma unroll
            for (int s = 0; s < 4; ++s) { z0 = SBA_MFMA(kf[2 * s], qr[s], z0); z1 = SBA_MFMA(kf[2 * s + 1], qr[s], z1); }
            if (jb >= 0) { const int kb = 64 * jb + 4 * hi;
#pragma unroll
                for (int r = 0; r < 16; ++r) { const int kv = kb + (r & 3) + 8 * (r >> 2); if (kv >= qrel) z0[r] = -INFINITY; if (kv + 32 >= qrel) z1[r] = -INFINITY; } }
            f32x16 s0, s1;
#pragma unroll
            for (int r = 0; r < 16; ++r) { s0[r] = fmaxf(z0[r], 0.f) + __builtin_amdgcn_logf(1.0f + __builtin_amdgcn_exp2f(-fabsf(z0[r]))); s1[r] = fmaxf(z1[r], 0.f) + __builtin_amdgcn_logf(1.0f + __builtin_amdgcn_exp2f(-fabsf(z1[r]))); }
            const bf16x8 f00 = pack8(s0, 0), f01 = pack8(s0, 8), f10 = pack8(s1, 0), f11 = pack8(s1, 8);
            f32x16 Dv = SBA_MFMA(J, f10, C); Dv = SBA_MFMA(J, f11, Dv);
            f32x16 c1 = SBA_MFMA(U0, f10, C); c1 = SBA_MFMA(U1, f11, c1);
            f32x16 c0 = SBA_MFMA(U0, f00, Dv); c0 = SBA_MFMA(U1, f01, c0);
            C = SBA_MFMA(J, f00, Dv); C = SBA_MFMA(J, f01, C);
#pragma unroll
            for (int r = 0; r < 16; ++r) { z0[r] = __builtin_amdgcn_exp2f(z0[r] - c0[r]); z1[r] = __builtin_amdgcn_exp2f(z1[r] - c1[r]); }
            const bf16x8 p0 = pack8(z0, 0), p1 = pack8(z0, 8), p2 = pack8(z1, 0), p3 = pack8(z1, 8);
            pv(o, vb0 + slot, p0, p1, p2, p3);
            if (__all(C[0] >= CARRY_ZERO)) { wdone = true; if (lane == 0) flg[wid] = i; }
        }
        SBA_WAIT_BAR();
        { int m = flg[0];
#pragma unroll
          for (int w = 1; w < 8; ++w) { const int f = flg[w]; m = f > m ? f : m; }
          if (__builtin_amdgcn_readfirstlane(m) <= i) break; }
    }
    { unsigned short* stg = (unsigned short*)(shm + LDS_OST) + wid * 2048;
#pragma unroll
      for (int r = 0; r < 16; ++r) { const int orow = crow(r, hi);
#pragma unroll
          for (int d0 = 0; d0 < 2; ++d0) stg[orow * 64 + d0 * 32 + r32] = (unsigned short)(cvtpk_s(o[d0][r], 0.f) & 0xffffu); }
      asm volatile("s_waitcnt lgkmcnt(0)" ::: "memory");
      const __amdgpu_buffer_rsrc_t rmix = __builtin_amdgcn_make_buffer_rsrc((void*)MIX, (short)0, (int)(16384u * 1024u * 2u), 0x00020000);
#pragma unroll
      for (int i = 0; i < 4; ++i) { const int row = i * 8 + (lane >> 3), ch = lane & 7; const u32x4 v = *(const u32x4*)(stg + row * 64 + ch * 8); __builtin_amdgcn_raw_buffer_store_b128(v, rmix, (int)(((rowbase + q0 + wid * 32 + row) * D + MIXOFF + h * 64 + ch * 8) * 2), 0, 16); } }
    asm volatile("s_waitcnt lgkmcnt(0)\n\ts_barrier" ::: "memory");
#undef SBA_DMA
}
}

constexpr int NWAVES = 8;
#ifndef MK_N_LAUNCHES
#define MK_N_LAUNCHES 1
#endif
constexpr int N_PHASES = 12;
constexpr size_t MiB = 1u << 20;
constexpr size_t WS_CTL = 0, CTL_ZERO_BYTES = 64 * 1024;
constexpr int CW_BAR = 4096;
constexpr size_t WS_SSPA = 1 * MiB, WS_SSPB = WS_SSPA + 256 * 1024, WS_BO = WS_SSPB + 256 * 1024;
constexpr size_t WS_WIN = 2 * MiB, WS_WOUT = 11 * MiB, WS_WUP = 15 * MiB, WS_WDN = 37 * MiB;
constexpr size_t WS_XB = 48 * MiB;
constexpr size_t WS_R = 81 * MiB, WS_PROJ = WS_R, WS_MIX = WS_R + 72 * MiB, WS_H = WS_R, WS_END = WS_R + 104 * MiB;
static_assert(WS_XB + (size_t)(M + 256) * D * 2 <= WS_R && WS_END <= 256 * MiB && WS_H + (size_t)M * DFF * 2 <= WS_END && WS_MIX + (size_t)M * D * 2 <= WS_END, "ws map");
constexpr int RING_OFF = 0, RING_BYTES = 131072, XL_OFF = RING_BYTES, LDSCTL_OFF = XL_OFF + 4096, MISC_OFF = LDSCTL_OFF + 320, LDS_BYTES = 147456;

struct Frame { LAS unsigned char* lds; volatile LAS unsigned* MISC; gu32* ctl; int tid, lane, wave, vcu, G; };
__device__ __forceinline__ float wave_sum(float v) { return pg8::wave_sum_all(v); }
__device__ __forceinline__ float bf2f(unsigned short b) { return __builtin_bit_cast(float, (unsigned)b << 16); }
__device__ __forceinline__ int map_in(int n) { const int t = n >> 8, j = n & 255; return (t < 2) ? ((j < 128) ? 128 * t + j : 256 + 128 * t + (j - 128)) : n; }
__device__ __forceinline__ int map_up(int n) { const int t = n >> 8, j = n & 255; return (j < 128) ? 128 * t + j : DFF + 128 * t + (j - 128); }

__device__ __forceinline__ void p0_transpose_item(const float* W, int K, int N, const float* g, bf16* WT, int src0, int n0, int k0, LAS float* scr, int lane, float cs = 1.0f) {
    float wv[32];
#pragma unroll
    for (int i = 0; i < 32; ++i) wv[i] = W[(size_t)(k0 + 2 * i + (lane >> 5)) * N + src0 + (lane & 31)];
#pragma unroll
    for (int i = 0; i < 32; ++i) { const int kk = 2 * i + (lane >> 5); float v = wv[i]; if (g) v *= g[k0 + kk]; scr[kk * 33 + (lane & 31)] = v * cs; }
    LDS_WAIT(); asm volatile("" ::: "memory");
    const int c = lane & 7;
#pragma unroll
    for (int j = 0; j < 4; ++j) { const int n = (lane >> 3) + 8 * j; const LAS float* s = scr + (8 * c) * 33 + n;
        v4u o; o.x = pk2(s[0 * 33], s[1 * 33]); o.y = pk2(s[2 * 33], s[3 * 33]); o.z = pk2(s[4 * 33], s[5 * 33]); o.w = pk2(s[6 * 33], s[7 * 33]);
        *(v4u*)(WT + (size_t)(n0 + n) * K + k0 + 8 * c) = o; }
    LDS_WAIT(); asm volatile("" ::: "memory");
}
struct Ptrs {
    const float *x, *norm1_g, *w_in, *cdw_w, *cdw_b, *cln_g, *cln_b, *cpw_w, *cpw_b, *pool_w, *pool_scale, *w_out, *norm2_g, *ffn_up, *fdw_w, *fdw_b, *ffn_down, *final_g;
    float* out; float *SSPA, *SSPB, *BO; bf16 *WIN, *WOUT, *WUP, *WDN, *XB, *PROJ, *MIX, *H;
};
__device__ __forceinline__ void p0_prologue(Frame& F, const Ptrs& P) {
    LAS float* scr = (LAS float*)(F.lds + RING_OFF + F.wave * 16384);
    const int gw = F.vcu * NWAVES + F.wave, NGW = F.G * NWAVES, lane = F.lane;
    constexpr int I_IN = 16 * 72, I_UP = 16 * 176, I_DN = 44 * 32, I_L = I_IN + I_UP + I_DN;
    for (int it = gw; it < DEPTH * I_L; it += NGW) {
        const int l = it / I_L; int r = it % I_L;
        if (r < I_IN) { const int kb = r / 72, nb = r % 72; p0_transpose_item(P.w_in + (size_t)l * D * DIN, D, DIN, P.norm1_g + l * D, P.WIN + (size_t)l * DIN * D, map_in(32 * nb), 32 * nb, 64 * kb, scr, lane, (32 * nb >= 768 && 32 * nb < 1280) ? 0.125f * 1.4426950408889634f : 1.0f); continue; } r -= I_IN;
        if (r < I_UP) { const int kb = r / 176, nb = r % 176; p0_transpose_item(P.ffn_up + (size_t)l * D * DUP, D, DUP, P.norm2_g + l * D, P.WUP + (size_t)l * DUP * D, map_up(32 * nb), 32 * nb, 64 * kb, scr, lane); continue; } r -= I_UP;
        { const int kb = r / 32, nb = r % 32; p0_transpose_item(P.ffn_down + (size_t)l * DFF * D, DFF, D, nullptr, P.WDN + (size_t)l * D * DFF, 32 * nb, 32 * nb, 64 * kb, scr, lane); }
    }
    for (int it = gw; it < DEPTH * 64 * 16; it += NGW) {
        const int l = it / 1024, kg = (it % 1024) / 16, nt = it % 16, k0 = 4 * kg, n = 64 * nt + lane;
        const float* wo = P.w_out + (size_t)l * D * D + n; const float* pw = P.cpw_w + (size_t)l * DCONV * DCONV + (size_t)k0 * DCONV; float acc[4] = {0.f, 0.f, 0.f, 0.f};
        for (int j0 = 0; j0 < 256; j0 += 32) { float wv[32];
#pragma unroll
            for (int u = 0; u < 32; ++u) wv[u] = wo[(size_t)(j0 + u) * D];
#pragma unroll
            for (int u = 0; u < 32; ++u)
#pragma unroll
                for (int i = 0; i < 4; ++i) acc[i] += pw[i * DCONV + j0 + u] * wv[u]; }
        *(unsigned long long*)(P.WOUT + (size_t)l * D * D + (size_t)n * D + k0) = (unsigned long long)pk2(acc[0], acc[1]) | ((unsigned long long)pk2(acc[2], acc[3]) << 32);
    }
    for (int it = gw; it < DEPTH * 64 * 16; it += NGW) {
        const int l = it / 1024, kg = (it % 1024) / 16, nt = it % 16, k0 = 256 + 4 * kg, n = 64 * nt + lane;
        const int g = (k0 - 256) >> 6, c0 = (k0 - 256) & 63; const float* pw = P.pool_w + (size_t)l * 4 * 64 * 64 + (size_t)(g * 64 + c0) * 64; const float* ps = P.pool_scale + l * DPOOL + 64 * g;
        const float* wo = P.w_out + (size_t)l * D * D + (size_t)(256 + 64 * g) * D + n; float acc[4] = {0.f, 0.f, 0.f, 0.f};
        for (int d0 = 0; d0 < 64; d0 += 8) { float wv[8];
#pragma unroll
            for (int u = 0; u < 8; ++u) wv[u] = ps[d0 + u] * wo[(size_t)(d0 + u) * D];
#pragma unroll
            for (int u = 0; u < 8; ++u)
#pragma unroll
                for (int i = 0; i < 4; ++i) acc[i] += pw[i * 64 + d0 + u] * wv[u]; }
        *(unsigned long long*)(P.WOUT + (size_t)l * D * D + (size_t)n * D + k0) = (unsigned long long)pk2(acc[0], acc[1]) | ((unsigned long long)pk2(acc[2], acc[3]) << 32);
    }
    for (int it = gw; it < DEPTH * 64 * 16; it += NGW) {
        const int l = it / 1024, kg = (it % 1024) / 16, nt = it % 16, k0 = 512 + 8 * kg, n = 64 * nt + lane;
        const float* wo = P.w_out + (size_t)l * D * D + n; float acc[8];
#pragma unroll
        for (int i = 0; i < 8; ++i) acc[i] = wo[(size_t)(k0 + i) * D];
        v4u o; o.x = pk2(acc[0], acc[1]); o.y = pk2(acc[2], acc[3]); o.z = pk2(acc[4], acc[5]); o.w = pk2(acc[6], acc[7]);
        *(v4u*)(P.WOUT + (size_t)l * D * D + (size_t)n * D + k0) = o;
    }
    for (int it = gw; it < DEPTH * 16; it += NGW) { const int l = it / 16, n = 64 * (it % 16) + lane; float acc = 0.f;
        for (int j = 0; j < 256; ++j) acc += P.cpw_b[l * DCONV + j] * P.w_out[(size_t)l * D * D + (size_t)j * D + n];
        P.BO[l * D + n] = acc; }
    for (int r0 = 4 * gw; r0 < M; r0 += 4 * NGW) {
        f32x4 v[4][4];
#pragma unroll
        for (int q = 0; q < 4; ++q)
#pragma unroll
            for (int j = 0; j < 4; ++j) v[q][j] = ((const f32x4*)(P.x + (size_t)(r0 + q) * D) + lane)[64 * j];
#pragma unroll
        for (int q = 0; q < 4; ++q) { float s = 0.f; unsigned long long* o = (unsigned long long*)(P.XB + (size_t)(r0 + q) * D) + lane;
#pragma unroll
            for (int j = 0; j < 4; ++j) { const f32x4 t = v[q][j]; s += (t.x * t.x + t.y * t.y) + (t.z * t.z + t.w * t.w); o[64 * j] = (unsigned long long)pk2(t.x, t.y) | ((unsigned long long)pk2(t.z, t.w) << 32); }
            s = wave_sum(s); if (lane == 0) *(f32x4*)(P.SSPB + (size_t)(r0 + q) * 4) = (f32x4){s, 0.f, 0.f, 0.f}; }
    }
}
__device__ __forceinline__ void convpool_unit(Frame& F, const Ptrs& P, int l, int t0) {
    bf16* Ul = (bf16*)(F.lds + RING_OFF); float* Y = (float*)(F.lds + RING_OFF + 94 * 256 * 2);
    LAS bf16* UlL = (LAS bf16*)(F.lds + RING_OFF); LAS float* YL = (LAS float*)(F.lds + RING_OFF + 94 * 256 * 2); (void)Ul; (void)Y;
    const int tid = F.tid, tl = t0 % SEQ; const bf16* PR = P.PROJ;
    { v4u av[6], gv[6];
#pragma unroll
      for (int k = 0; k < 6; ++k) { const int i = tid + 512 * k; const int r = i >> 5, ch = i & 31, c0 = ch * 8, tt = c0 >> 7, j = c0 & 127; const int tok = tl - 30 + r;
          const int rr = (r > 93 ? 93 : r), rowc = (tok >= 0) ? (t0 - 30 + rr) : t0;
          const bf16* rp = PR + (size_t)rowc * DIN + 256 * tt + j; av[k] = *(const v4u*)rp; gv[k] = *(const v4u*)(rp + 128);
          if (tok < 0) { av[k] = (v4u){0u, 0u, 0u, 0u}; gv[k] = av[k]; } }
#pragma unroll
      for (int k = 0; k < 6; ++k) { const int i = tid + 512 * k; const int r = i >> 5, ch = i & 31, c0 = ch * 8; unsigned ov[4];
#pragma unroll
          for (int q = 0; q < 4; ++q) { const unsigned aw = av[k][q], gw_ = gv[k][q];
              const float a0 = bf2f((unsigned short)(aw & 0xffff)), a1 = bf2f((unsigned short)(aw >> 16)), g0 = bf2f((unsigned short)(gw_ & 0xffff)), g1 = bf2f((unsigned short)(gw_ >> 16));
              ov[q] = pk2(a0 / (1.0f + __expf(-g0)), a1 / (1.0f + __expf(-g1))); }
          if (i < 94 * 32) *(LAS v4u*)(UlL + r * 256 + c0) = (v4u){ov[0], ov[1], ov[2], ov[3]}; } }
    __syncthreads();
    const int c = tid & 255, half = tid >> 8;
    const int tb = tl + half * 32; const bf16* pc = PR + 512 + c; unsigned short pv_[47];
#pragma unroll
    for (int k = 0; k < 47; ++k) { const int tok = tb - 15 + k; pv_[k] = pc[(size_t)(t0 + half * 32 + (tok >= 0 ? k - 15 : 0)) * DIN]; }
#pragma unroll
    for (int k = 0; k < 15; ++k) if (tb - 15 + k < 0) pv_[k] = (unsigned short)0;
    { const float* dw_w = P.cdw_w + (size_t)l * CONVK * DCONV; float w[CONVK];
#pragma unroll
      for (int i = 0; i < CONVK; ++i) w[i] = dw_w[i * DCONV + c];
      const float bb = P.cdw_b[l * DCONV + c];
#pragma unroll 1
      for (int g = 0; g < 2; ++g) { const int tbq = half * 32 + g * 16; float in[46];
#pragma unroll
          for (int i = 0; i < 46; ++i) in[i] = bf2f(UlL[(tbq + i) * 256 + c]);
#pragma unroll
          for (int q = 0; q < 16; ++q) { float acc = bb;
#pragma unroll
              for (int i = 0; i < CONVK; ++i) acc += w[i] * in[q + i];
              YL[(tbq + q) * 256 + c] = acc; } } }
    __syncthreads();
    { const int wv = F.wave, lane = F.lane; const f32x4 gg = ((const f32x4*)(P.cln_g + l * DCONV))[lane], bbv = ((const f32x4*)(P.cln_b + l * DCONV))[lane];
      f32x4 y[8]; float s1[8], s2[8];
#pragma unroll
      for (int q = 0; q < 8; ++q) { y[q] = ((const LAS f32x4*)(YL + (wv * 8 + q) * 256))[lane]; s1[q] = (y[q].x + y[q].y) + (y[q].z + y[q].w); }
#pragma unroll
      for (int q = 0; q < 8; ++q) s1[q] += pg8::swz_xor<1>(s1[q]);
#pragma unroll
      for (int q = 0; q < 8; ++q) s1[q] += pg8::swz_xor<2>(s1[q]);
#pragma unroll
      for (int q = 0; q < 8; ++q) s1[q] += pg8::swz_xor<4>(s1[q]);
#pragma unroll
      for (int q = 0; q < 8; ++q) s1[q] += pg8::swz_xor<8>(s1[q]);
#pragma unroll
      for (int q = 0; q < 8; ++q) s1[q] += pg8::swz_xor<16>(s1[q]);
#pragma unroll
      for (int q = 0; q < 8; ++q) { const float mu = pg8::add_xor32(s1[q]) * (1.0f / 256.0f); y[q] = y[q] - mu; s2[q] = (y[q].x * y[q].x + y[q].y * y[q].y) + (y[q].z * y[q].z + y[q].w * y[q].w); }
#pragma unroll
      for (int q = 0; q < 8; ++q) s2[q] += pg8::swz_xor<1>(s2[q]);
#pragma unroll
      for (int q = 0; q < 8; ++q) s2[q] += pg8::swz_xor<2>(s2[q]);
#pragma unroll
      for (int q = 0; q < 8; ++q) s2[q] += pg8::swz_xor<4>(s2[q]);
#pragma unroll
      for (int q = 0; q < 8; ++q) s2[q] += pg8::swz_xor<8>(s2[q]);
#pragma unroll
      for (int q = 0; q < 8; ++q) s2[q] += pg8::swz_xor<16>(s2[q]);
#pragma unroll
      for (int q = 0; q < 8; ++q) { const float rs = 1.0f / sqrtf(pg8::add_xor32(s2[q]) * (1.0f / 256.0f) + EPS);
          f32x4 z = y[q] * rs * gg + bbv; z.x = z.x / (1.0f + __expf(-z.x)); z.y = z.y / (1.0f + __expf(-z.y)); z.z = z.z / (1.0f + __expf(-z.z)); z.w = z.w / (1.0f + __expf(-z.w));
          *(unsigned long long*)(P.MIX + (size_t)(t0 + wv * 8 + q) * D + 4 * lane) = (unsigned long long)pk2(z.x, z.y) | ((unsigned long long)pk2(z.z, z.w) << 32); } }
    { const int win = 2 << (c >> 6);
#pragma unroll
      for (int q = 0; q < 32; ++q) { float s = 0.f;
#pragma unroll
          for (int j = 0; j < 16; ++j) s += (j < win) ? bf2f(pv_[15 + q - j]) : 0.f;
          const int tloc = tb + q; const int cnt = (tloc + 1 < win) ? tloc + 1 : win;
          P.MIX[(size_t)(t0 + half * 32 + q) * D + 256 + c] = (bf16)f2bf(s / (float)cnt - bf2f(pv_[15 + q])); } }
    __syncthreads();
}
__device__ __forceinline__ void mixers_phase(Frame& F, const Ptrs& P, int l) {
#ifdef DBG_MIX_T
    volatile LAS unsigned long long* TSm = (volatile LAS unsigned long long*)(F.lds + MISC_OFF + 256); if (blockIdx.x == 0 && F.tid == 0) TSm[38] = rt();
#endif
    for (int u = F.vcu; u < M / 64; u += F.G) convpool_unit(F, P, l, 64 * u);
#ifdef DBG_MIX_T
    if (blockIdx.x == 0 && F.tid == 0) { const unsigned long long t1 = rt(); TSm[36] += t1 - TSm[38]; TSm[38] = t1; }
#endif
    for (int k = 0; k < 2; ++k) for (int c = F.vcu; c < 256; c += F.G) { const int bh = c >> 2, j = c & 3, qb = k ? 7 - j : j;
        sba::attn_unit(bh >> 3, bh & 7, qb, P.PROJ, P.MIX, (char*)F.lds + RING_OFF, F.wave, F.lane); }
#ifdef DBG_MIX_T
    if (blockIdx.x == 0 && F.tid == 0) { TSm[37] += rt() - TSm[38]; }
#endif
}
__device__ __forceinline__ void final_phase(Frame& F, const Ptrs& P) {
    const int gw = F.vcu * NWAVES + F.wave, NGW = F.G * NWAVES, lane = F.lane;
    for (int r0 = 2 * gw; r0 < M; r0 += 2 * NGW) {
        v4u xb[2][2]; float r[2];
#pragma unroll
        for (int q = 0; q < 2; ++q) { xb[q][0] = ((const v4u*)(P.XB + (size_t)(r0 + q) * D))[lane]; xb[q][1] = ((const v4u*)(P.XB + (size_t)(r0 + q) * D))[64 + lane]; r[q] = pg8::rs_from_ssp(P.SSPB, r0 + q); }
#pragma unroll
        for (int q = 0; q < 2; ++q)
#pragma unroll
            for (int hf = 0; hf < 2; ++hf) { const f32x4* gr = (const f32x4*)(P.final_g + 512 * hf + 8 * lane); f32x4* o = (f32x4*)(P.out + (size_t)(r0 + q) * D + 512 * hf + 8 * lane); const v4u w = xb[q][hf];
                f32x4 a, b2; a[0] = __builtin_bit_cast(float, w[0] << 16); a[1] = __builtin_bit_cast(float, w[0] & 0xffff0000u); a[2] = __builtin_bit_cast(float, w[1] << 16); a[3] = __builtin_bit_cast(float, w[1] & 0xffff0000u);
                b2[0] = __builtin_bit_cast(float, w[2] << 16); b2[1] = __builtin_bit_cast(float, w[2] & 0xffff0000u); b2[2] = __builtin_bit_cast(float, w[3] << 16); b2[3] = __builtin_bit_cast(float, w[3] & 0xffff0000u);
                o[0] = a * r[q] * gr[0]; o[1] = b2 * r[q] * gr[1]; }
    }
}

#define MKP() Ptrs P; do { unsigned char* ws = args.ws; asm volatile("" : "+s"(ws)); P.x = args.in[0]; P.norm1_g = args.in[1]; P.w_in = args.in[2]; P.cdw_w = args.in[3]; P.cdw_b = args.in[4]; P.cln_g = args.in[5]; P.cln_b = args.in[6]; P.cpw_w = args.in[7]; P.cpw_b = args.in[8]; P.pool_w = args.in[9]; P.pool_scale = args.in[10]; P.w_out = args.in[11]; P.norm2_g = args.in[12]; P.ffn_up = args.in[13]; P.fdw_w = args.in[14]; P.fdw_b = args.in[15]; P.ffn_down = args.in[16]; P.final_g = args.in[17]; P.out = args.out; P.SSPA = (float*)(ws + WS_SSPA); P.SSPB = (float*)(ws + WS_SSPB); P.BO = (float*)(ws + WS_BO); P.WIN = (bf16*)(ws + WS_WIN); P.WOUT = (bf16*)(ws + WS_WOUT); P.WUP = (bf16*)(ws + WS_WUP); P.WDN = (bf16*)(ws + WS_WDN); P.XB = (bf16*)(ws + WS_XB); P.PROJ = (bf16*)(ws + WS_PROJ); P.MIX = (bf16*)(ws + WS_MIX); P.H = (bf16*)(ws + WS_H); } while (0)
struct Args { const float* in[18]; float* out; unsigned char* ws; int ph_lo, ph_hi; };
__global__ void __launch_bounds__(NWAVES * 64, 2) mega_fwd(Args args) {
    extern __shared__ __attribute__((aligned(16))) unsigned char lds[];
    Frame F;
    F.lds = (LAS unsigned char*)lds; F.MISC = (volatile LAS unsigned*)(F.lds + MISC_OFF);
    F.tid = threadIdx.x; F.lane = F.tid & 63; F.wave = __builtin_amdgcn_readfirstlane(F.tid >> 6);
    F.G = gridDim.x; { const int bx = blockIdx.x; F.vcu = (F.G % 8 == 0) ? (bx % 8) * (F.G / 8) + bx / 8 : bx; }
    F.ctl = (gu32*)(args.ws + WS_CTL);
    for (int u = F.tid; u < (LDS_BYTES - LDSCTL_OFF) / 4; u += NWAVES * 64) ((LAS unsigned*)(F.lds + LDSCTL_OFF))[u] = 0u;
    __syncthreads();
    const int lo = args.ph_lo, hi = args.ph_hi;
    const bool use_bar = (hi - lo) > 1;
    XcdBarrier bar; bar.bar = (unsigned*)(F.ctl + CW_BAR); bar.x = 0; bar.st = nullptr;
    if (use_bar) bar = xcd_barrier_post((unsigned*)(F.ctl + CW_BAR), F.MISC + 8);
#define REFRESH() do { int l_; asm volatile("v_mbcnt_lo_u32_b32 %0, -1, 0\n\tv_mbcnt_hi_u32_b32 %0, -1, %0" : "=v"(l_)); F.lane = l_; F.tid = 64 * F.wave + l_; } while (0)
#define LAUNDER_S(v) asm volatile("" : "+s"(v))
#ifdef DBG_TIMING
#ifndef DBG_GT_ST
#define DBG_GT_ST 3
#endif
    volatile LAS unsigned long long* TS = (volatile LAS unsigned long long*)(F.lds + MISC_OFF + 256);
    const bool stamper = (blockIdx.x == 0 && threadIdx.x == 0);
    if (stamper) { TS[0] = rt(); TS[16] = 0; TS[32] = 0; TS[33] = 0; TS[34] = 0; TS[35] = 0; TS[36] = 0; TS[37] = 0; }
#endif
#pragma nounroll
    for (int ph_ = lo; ph_ < hi; ++ph_) {
        int ph = ph_; LAUNDER_S(ph);
        const int l = (ph - 1) / 5, st = (ph == 0) ? -1 : (ph == N_PHASES - 1 ? 5 : (ph - 1) % 5);
        int bx = (int)blockIdx.x; LAUNDER_S(bx);
        MKP();
        if (st == -1) { }
        else if (st == 0) {
            pg8::Gemm g{P.XB, P.WIN + (size_t)l * DIN * D, M, DIN, D}; pg8::StaticOrder S; S.init(M, DIN, F.G, bx);
            pg8::EpiProj E{P.PROJ, DIN, P.SSPB};
            pg8::gemm_phase<pg8::EpiProj, pg8::StaticOrder, PG8_ALIGN, PG8_SP2>(F.lds + RING_OFF, g, S, E, F.wave); }
        else if (st == 1) { REFRESH(); mixers_phase(F, P, l); }
        else if (st == 2 || st == 4) {
            const bool o = (st == 2);
            pg8::Gemm g{o ? P.MIX : P.H, o ? P.WOUT + (size_t)l * D * D : P.WDN + (size_t)l * D * DFF, M, D, o ? D : DFF}; pg8::StaticOrder S; S.init(M, D, F.G, bx);
            pg8::EpiRes E{P.XB, o ? P.BO + l * D : nullptr, o ? P.SSPA : P.SSPB};
            pg8::gemm_phase<pg8::EpiRes, pg8::StaticOrder, false, PG8_SP2>(F.lds + RING_OFF, g, S, E, F.wave); }
        else if (st == 3) {
            pg8::Gemm g{P.XB, P.WUP + (size_t)l * DUP * D, M + 256, DUP, D}; pg8::StaticOrder S; S.init(M + 256, DUP, F.G, bx);
            pg8::EpiUp E{P.H, P.SSPA, P.fdw_w + (size_t)l * 3 * DFF, P.fdw_b + (size_t)l * DFF, (LAS float*)(F.lds + XL_OFF)};
            pg8::gemm_phase<pg8::EpiUp, pg8::StaticOrder, true, PG8_SP2>(F.lds + RING_OFF, g, S, E, F.wave); }
        else { REFRESH(); final_phase(F, P); }
#ifdef DBG_TIMING
        unsigned long long tb0 = 0; if (stamper) tb0 = rt();
#endif
        if (st == -1) { REFRESH(); p0_prologue(F, P); }
        if (ph_ + 1 < hi) xcd_barrier(bar);
#ifdef DBG_TIMING
        if (stamper) { TS[ph_ + 1] = rt(); TS[16] += TS[ph_ + 1] - tb0;
            if (st == DBG_GT_ST) { TS[34] = TS[32]; TS[35] = TS[33]; } else { TS[32] = TS[34]; TS[33] = TS[35]; } }
#endif
    }
#ifdef DBG_TIMING
    if (stamper) { asm volatile("s_waitcnt vmcnt(0) lgkmcnt(0)" ::: "memory");
        float g[8];
        auto dd = [&](int k) { return (float)(TS[k + 1] - TS[k]) * 0.01f; };
        g[0] = dd(0); g[1] = dd(1) + dd(6); g[2] = dd(2) + dd(7); g[3] = dd(3) + dd(8); g[4] = dd(4) + dd(9); g[5] = dd(5) + dd(10); g[6] = dd(11); g[7] = (float)(TS[12] - TS[0]) * 0.01f;
        float g8 = (float)TS[16] * 0.01f, g9 = (float)TS[32] * 0.01f, g10 = (float)TS[33] * 0.01f;
#ifdef DBG_MIX_T
        g9 = (float)TS[36] * 0.01f; g10 = (float)TS[37] * 0.01f;
#endif (void)g8; (void)g9; (void)g10;
        args.out[0] = 0.25f * (DBG_SEL0 < 8 ? g[DBG_SEL0 & 7] : (DBG_SEL0 == 8 ? g8 : (DBG_SEL0 == 9 ? g9 : g10))); args.out[1] = 0.25f * (DBG_SEL1 < 8 ? g[DBG_SEL1 & 7] : (DBG_SEL1 == 8 ? g8 : (DBG_SEL1 == 9 ? g9 : g10))); }
#endif
}

extern "C" void kernel_launch(void* const* d_in, const int* in_sizes, int n_in, void* d_out, int out_size, void* d_ws, size_t ws_size, hipStream_t stream) {
    static int grid = 0;
    if (grid == 0) {
        if (n_in != 18 || in_sizes[0] != M * D || out_size != M * D || ws_size < WS_END) { fprintf(stderr, "kernel_launch: unexpected shapes (n_in %d, ws %zu)\n", n_in, ws_size); grid = -1; return; }
        int dev = 0, cus = 0, per_cu = 0;
        if (hipGetDevice(&dev) != hipSuccess || hipDeviceGetAttribute(&cus, hipDeviceAttributeMultiprocessorCount, dev) != hipSuccess) { grid = -1; return; }
        if (hipFuncSetAttribute((const void*)mega_fwd, hipFuncAttributeMaxDynamicSharedMemorySize, LDS_BYTES) != hipSuccess) { fprintf(stderr, "kernel_launch: hipFuncSetAttribute failed\n"); grid = -1; return; }
        if (hipOccupancyMaxActiveBlocksPerMultiprocessor(&per_cu, (const void*)mega_fwd, NWAVES * 64, LDS_BYTES) != hipSuccess || per_cu < 1) { fprintf(stderr, "kernel_launch: occupancy query says %d blocks per CU\n", per_cu); }
        (void)hipGetLastError();
        grid = cus;
        if (grid != 256) fprintf(stderr, "kernel_launch: %d CUs (the fused epilogues assume 256)\n", grid);
    }
    if (grid < 0) return;
    (void)hipMemsetAsync((char*)d_ws + WS_CTL, 0, CTL_ZERO_BYTES, stream);
    Args a{};
    for (int i = 0; i < 18; ++i) a.in[i] = (const float*)d_in[i];
    a.out = (float*)d_out; a.ws = (unsigned char*)d_ws;
    if (MK_N_LAUNCHES == 1) { a.ph_lo = 0; a.ph_hi = N_PHASES; hipLaunchKernelGGL(mega_fwd, dim3(grid), dim3(NWAVES * 64), LDS_BYTES, stream, a); }
    else for (int p = 0; p < N_PHASES; ++p) { a.ph_lo = p; a.ph_hi = p + 1; hipLaunchKernelGGL(mega_fwd, dim3(grid), dim3(NWAVES * 64), LDS_BYTES, stream, a); }
}
```

```cpp
#include <hip/hip_runtime.h>
#include <cstdio>
#include <cstdint>
constexpr int D = 1024, BATCH = 8, SEQ = 2048, DEPTH = 2, M = BATCH * SEQ;
constexpr int DCONV = 256, DPOOL = 256, DATT = 512, NH = 8, HD = 64, CONVK = 31, DFF = 2816, DIN = 2304, DUP = 2 * DFF;
constexpr float EPS = 1e-6f;
namespace pg8 {
#define PG8_LAS __attribute__((address_space(3)))
typedef unsigned short bf16_t;
typedef short bf16x8 __attribute__((ext_vector_type(8)));
typedef float f32x4 __attribute__((ext_vector_type(4)));
typedef unsigned u32x4 __attribute__((ext_vector_type(4)));
constexpr int BM = 256, BK = 64, HALF = 128, HTB = HALF * BK * 2  , STAGE_BYTES = 8 * HTB, NXCD = 8, WGM = 8;

__host__ __device__ __forceinline__ int lds_byte(int r, int c) { const int st = (r >> 4) * 2 + (c >> 5), rr = r & 15, cc = c & 31, ob = rr * 64 + cc * 2; return st * 1024 + (ob ^ (((ob >> 9) & 1) << 5)); }
__host__ __device__ __forceinline__ void stage_rc(int b, int& R, int& C) { const int st = b / 1024, sb = b % 1024, swz = sb ^ (((sb >> 9) & 1) << 5); R = (st >> 1) * 16 + swz / 64; C = (st & 1) * 32 + (swz % 64) / 2; }
__host__ __device__ __forceinline__ int perm32(int rho) { const int n = rho >> 4, i = rho & 15; return 8 * (i >> 2) + 4 * n + (i & 3); }

struct Unit { int pm, pn; };
struct Gemm { const bf16_t* A; const bf16_t* Bt; int M, N, K; };

struct StaticOrder {
    int nM, nN, nwg, G, c;
    __host__ __device__ void init(int M, int N, int G_, int c_) { nM = M / BM; nN = N / BM; nwg = nM * nN; G = G_; c = c_; }
    __host__ __device__ bool next(int i, Unit& u) const {
        const long L = (long)i * G + c; if (L >= nwg) return false;
        int wgid = (int)L; { const int q = nwg / NXCD, r = nwg % NXCD, xcd = wgid % NXCD, off = wgid / NXCD; wgid = (xcd < r ? xcd * (q + 1) : r * (q + 1) + (xcd - r) * q) + off; }
        const int nig = WGM * nN, gid = wgid / nig, fm = gid * WGM, gsz = (nM - fm) < WGM ? (nM - fm) : WGM;
        u.pm = fm + ((wgid % nig) % gsz); u.pn = (wgid % nig) / gsz; return true;
    }
    __device__ __forceinline__ void a_ready(const Unit&) const {}
    __device__ __forceinline__ void done(const Unit&) const {}
};

__device__ __forceinline__ unsigned cvt_pk_bf16(float lo, float hi) { unsigned r; asm volatile("v_cvt_pk_bf16_f32 %0, %1, %2" : "=v"(r) : "v"(lo), "v"(hi)); return r; }
typedef float f32x2 __attribute__((ext_vector_type(2)));
__device__ __forceinline__ f32x2 gelu_pk(f32x2 v) {
    const f32x2 av = __builtin_elementwise_abs(v), d = av * 0.2316418882f + 1.0f;
    f32x2 t; t.x = __builtin_amdgcn_rcpf(d.x); t.y = __builtin_amdgcn_rcpf(d.y);
    f32x2 q = t * 0.5307027145f + (-0.7265760135f); q = q * t + 0.7107068705f; q = q * t + (-0.142248368f); q = q * t + 0.127414796f; q = q * t;
    const f32x2 s = (v * v) * (-0.72134752044f);
    f32x2 e; e.x = __builtin_amdgcn_exp2f(s.x); e.y = __builtin_amdgcn_exp2f(s.y);
    const f32x2 m = v * (q * e), r = v - m;
    f32x2 o; o.x = v.x < 0.f ? m.x : r.x; o.y = v.y < 0.f ? m.y : r.y; return o;
}
template <int X> __device__ __forceinline__ float swz_xor(float v) { return __builtin_bit_cast(float, __builtin_amdgcn_ds_swizzle(__builtin_bit_cast(int, v), (X << 10) | 0x1f)); }
__device__ __forceinline__ float add_xor32(float v) { float a = v, b = v; asm volatile("s_nop 1\n\tv_permlane32_swap_b32 %0, %1" : "+v"(a), "+v"(b)); return a + b; }
__device__ __forceinline__ float wave_sum_all(float v) { v += swz_xor<1>(v); v += swz_xor<2>(v); v += swz_xor<4>(v); v += swz_xor<8>(v); v += swz_xor<16>(v); return add_xor32(v); }
__device__ __forceinline__ float rs_from_s4(const f32x4 s) { return __builtin_amdgcn_rsqf(((s[0] + s[1]) + (s[2] + s[3])) * (1.0f / 1024.0f) + 1e-6f); }
__device__ __forceinline__ float rs_from_ssp(const float* ssp, int R) { return rs_from_s4(*(const f32x4*)(ssp + (size_t)R * 4)); }
template <int CTRL> __device__ __forceinline__ float dppf(float old, float src) { return __builtin_bit_cast(float, __builtin_amdgcn_update_dpp(__builtin_bit_cast(int, old), __builtin_bit_cast(int, src), CTRL, 0xf, 0xf, false)); }
constexpr int DPP_SHR1 = 0x111, DPP_SHR2 = 0x112, DPP_ROR1 = 0x121, DPP_ROR2 = 0x122;

__device__ __forceinline__ int lane_id_now() { int l; asm volatile("v_mbcnt_lo_u32_b32 %0, -1, 0\n\tv_mbcnt_hi_u32_b32 %0, -1, %0" : "=v"(l)); return l; }
typedef __amdgpu_buffer_rsrc_t rsrc_t;
__device__ __forceinline__ rsrc_t make_rsrc(void* p, unsigned bytes) { return __builtin_amdgcn_make_buffer_rsrc(p, (short)0, (int)bytes, 0x00020000); }
__device__ __forceinline__ void st16_wt(rsrc_t r, unsigned byte_off, u32x4 v) { __builtin_amdgcn_raw_buffer_store_b128(v, r, (int)byte_off, 0, 16); }
struct EpiProj {
    static constexpr bool PERM = true, AFTER_DRAIN = false;
    bf16_t* O; int ldc; const float* ssp;
    __device__ __forceinline__ void operator()(const f32x4 (&acc)[2][2][4][2], const Unit& u, int wr, int wc, int fr, int fq) const {
        { const int l_ = lane_id_now(); fr = l_ & 15; fq = l_ >> 4; }
        const int row0 = u.pm * BM + wr * 64 + fr, col0 = u.pn * BM + wc * 32 + 8 * fq; const rsrc_t ro = make_rsrc(O, 16384u * 2304u * 2u);
        f32x4 s4[2][4];
#pragma unroll
        for (int ai = 0; ai < 2; ++ai)
#pragma unroll
            for (int m = 0; m < 4; ++m) s4[ai][m] = *(const f32x4*)(ssp + (size_t)(row0 + ai * HALF + m * 16) * 4);
#pragma unroll
        for (int ai = 0; ai < 2; ++ai)
#pragma unroll
            for (int m = 0; m < 4; ++m) { const int R = row0 + ai * HALF + m * 16; const float sc = rs_from_s4(s4[ai][m]); const unsigned rowb = ((unsigned)R * (unsigned)ldc + (unsigned)col0) * 2u;
#pragma unroll
                for (int bj = 0; bj < 2; ++bj) { const f32x4 v0 = acc[ai][bj][m][0] * sc, v1 = acc[ai][bj][m][1] * sc;
                    u32x4 w; w.x = cvt_pk_bf16(v0[0], v0[1]); w.y = cvt_pk_bf16(v0[2], v0[3]); w.z = cvt_pk_bf16(v1[0], v1[1]); w.w = cvt_pk_bf16(v1[2], v1[3]);
                    st16_wt(ro, rowb + bj * HALF * 2, w); } }
    }
};
struct EpiUp {
    static constexpr bool PERM = true, AFTER_DRAIN = false;
    bf16_t* H; const float* ssp; const float* dww; const float* dwb; PG8_LAS float* xl;
    __device__ __forceinline__ void operator()(f32x4 (&acc)[2][2][4][2], const Unit& u, int wr, int wc, int fr, int fq) const {
        { const int l_ = lane_id_now(); fr = l_ & 15; fq = l_ >> 4; asm volatile("" : "+s"(wr), "+s"(wc)); }
        const bool halo = (u.pm == 64); const rsrc_t rh = make_rsrc(H, 16384u * 2816u * 2u);
        const int ch0 = u.pn * HALF + wc * 32 + 8 * fq;
        f32x4 s4[2][4];
#pragma unroll
        for (int ai = 0; ai < 2; ++ai)
#pragma unroll
            for (int m = 0; m < 4; ++m) { const int rt = ai * HALF + wr * 64 + m * 16 + fr; int R = halo ? 256 * (rt >> 2) - 2 + (rt & 3) : u.pm * BM + rt; R = R < 0 ? 0 : R; s4[ai][m] = *(const f32x4*)(ssp + (size_t)R * 4); }
#pragma unroll
        for (int ai = 0; ai < 2; ++ai)
#pragma unroll
            for (int m = 0; m < 4; ++m) {
                const float sc = rs_from_s4(s4[ai][m]);
#pragma unroll
                for (int bj = 0; bj < 2; ++bj)
#pragma unroll
                    for (int n = 0; n < 2; ++n) acc[ai][bj][m][n] *= sc; }
        if (fr >= 14) {
#pragma unroll
            for (int ai = 0; ai < 2; ++ai)
#pragma unroll
                for (int n = 0; n < 2; ++n) *(PG8_LAS f32x4*)(xl + ((ai * 2 + wr) * 4 + wc) * 64 + (fr - 14) * 32 + fq * 8 + n * 4) = acc[ai][1][3][n]; }
        asm volatile("s_waitcnt lgkmcnt(0)" ::: "memory"); __builtin_amdgcn_s_barrier(); asm volatile("" ::: "memory");
        f32x4 w0[2], w1[2], w2[2], bb[2];
#pragma unroll
        for (int n = 0; n < 2; ++n) { w0[n] = *(const f32x4*)(dww + ch0 + 4 * n); w1[n] = *(const f32x4*)(dww + DFF + ch0 + 4 * n); w2[n] = *(const f32x4*)(dww + 2 * DFF + ch0 + 4 * n); bb[n] = *(const f32x4*)(dwb + ch0 + 4 * n); }
#pragma unroll
        for (int ai = 0; ai < 2; ++ai)
#pragma unroll
            for (int m = 0; m < 4; ++m) {
                f32x4 prev[2];
                if (m > 0) { prev[0] = acc[ai][1][m - 1][0]; prev[1] = acc[ai][1][m - 1][1]; }
                else { prev[0] = (f32x4){0.f, 0.f, 0.f, 0.f}; prev[1] = prev[0];
                    const int sai = wr ? ai : ai - 1, swr = wr ? 0 : 1;
                    if (!halo && sai >= 0 && fr >= 14) {
#pragma unroll
                        for (int n = 0; n < 2; ++n) prev[n] = *(const PG8_LAS f32x4*)(xl + ((sai * 2 + swr) * 4 + wc) * 64 + (fr - 14) * 32 + fq * 8 + n * 4); } }
                f32x4 hv[2];
#pragma unroll
                for (int n = 0; n < 2; ++n) { const f32x4 cur = acc[ai][1][m][n]; f32x4 g1, g2;
#pragma unroll
                    for (int i = 0; i < 4; ++i) { const float p1 = halo ? 0.f : dppf<DPP_ROR1>(0.f, prev[n][i]), p2 = halo ? 0.f : dppf<DPP_ROR2>(0.f, prev[n][i]);
                        g1[i] = dppf<DPP_SHR1>(p1, cur[i]); g2[i] = dppf<DPP_SHR2>(p2, cur[i]); }
                    const f32x4 gc = w0[n] * g2 + w1[n] * g1 + w2[n] * cur + bb[n];
                    const f32x2 ga = gelu_pk((f32x2){gc[0], gc[1]}), gb = gelu_pk((f32x2){gc[2], gc[3]});
                    hv[n] = acc[ai][0][m][n] * (f32x4){ga.x, ga.y, gb.x, gb.y}; }
                const int rt = ai * HALF + wr * 64 + m * 16 + fr;
                u32x4 w; w.x = cvt_pk_bf16(hv[0][0], hv[0][1]); w.y = cvt_pk_bf16(hv[0][2], hv[0][3]); w.z = cvt_pk_bf16(hv[1][0], hv[1][1]); w.w = cvt_pk_bf16(hv[1][2], hv[1][3]);
                if (!halo) { if (!(rt < 2 && (u.pm & 7) != 0)) st16_wt(rh, ((unsigned)(u.pm * BM + rt) * (unsigned)DFF + (unsigned)ch0) * 2u, w); }
                else { const int k = rt >> 2, j = rt & 3; if (j >= 2 && (k & 7) != 0) st16_wt(rh, ((unsigned)(256 * k + j - 2) * (unsigned)DFF + (unsigned)ch0) * 2u, w); }
            }
    }
};
struct EpiRes {
    static constexpr bool PERM = true, AFTER_DRAIN = true;
    bf16_t* XB; const float* bias; float* sspo;
    __device__ __forceinline__ void fused(f32x4 (&acc)[2][2][4][2], const Unit& u, int wr, int wc, int fr, int fq, PG8_LAS unsigned char* lds, int wid, int lane) const {
        PG8_LAS float* P = (PG8_LAS float*)lds;
        { const int l_ = lane_id_now(); fr = l_ & 15; fq = l_ >> 4; lane = l_; }
        const int col0 = u.pn * BM + wc * 32 + 8 * fq; const rsrc_t rx = make_rsrc(XB, (16384u + 256u) * 1024u * 2u);
        f32x4 bv[2][2];
#pragma unroll
        for (int bj = 0; bj < 2; ++bj)
#pragma unroll
            for (int n = 0; n < 2; ++n) bv[bj][n] = bias ? *(const f32x4*)(bias + col0 + bj * HALF + 4 * n) : (f32x4){0.f, 0.f, 0.f, 0.f};
        u32x4 xin[2][4][2];
#pragma unroll
        for (int ai = 0; ai < 2; ++ai)
#pragma unroll
            for (int m = 0; m < 4; ++m)
#pragma unroll
                for (int bj = 0; bj < 2; ++bj) xin[ai][m][bj] = __builtin_amdgcn_raw_buffer_load_b128(rx, (int)(((unsigned)(u.pm * BM + ai * HALF + wr * 64 + m * 16 + fr) * 1024u + (unsigned)col0) * 2u + bj * HALF * 2), 0, 0);
#pragma unroll
        for (int ai = 0; ai < 2; ++ai)
#pragma unroll
            for (int m = 0; m < 4; ++m) { const int rt = ai * HALF + wr * 64 + m * 16 + fr, R = u.pm * BM + rt; const unsigned off = ((unsigned)R * 1024u + (unsigned)col0) * 2u; float s = 0.f;
                int hr = -1; if (rt < 2) hr = 16384 + 4 * u.pm + 2 + rt; else if (rt >= 254) hr = 16384 + 4 * (u.pm + 1) + (rt - 254);
#pragma unroll
                for (int bj = 0; bj < 2; ++bj) { const u32x4 xb = xin[ai][m][bj];
                    f32x4 x0, x1;
                    x0[0] = __builtin_bit_cast(float, xb[0] << 16); x0[1] = __builtin_bit_cast(float, xb[0] & 0xffff0000u); x0[2] = __builtin_bit_cast(float, xb[1] << 16); x0[3] = __builtin_bit_cast(float, xb[1] & 0xffff0000u);
                    x1[0] = __builtin_bit_cast(float, xb[2] << 16); x1[1] = __builtin_bit_cast(float, xb[2] & 0xffff0000u); x1[2] = __builtin_bit_cast(float, xb[3] << 16); x1[3] = __builtin_bit_cast(float, xb[3] & 0xffff0000u);
                    x0 = x0 + acc[ai][bj][m][0] + bv[bj][0]; x1 = x1 + acc[ai][bj][m][1] + bv[bj][1];
                    s += ((x0[0] * x0[0] + x0[1] * x0[1]) + (x0[2] * x0[2] + x0[3] * x0[3])) + ((x1[0] * x1[0] + x1[1] * x1[1]) + (x1[2] * x1[2] + x1[3] * x1[3]));
                    u32x4 w; w.x = cvt_pk_bf16(x0[0], x0[1]); w.y = cvt_pk_bf16(x0[2], x0[3]); w.z = cvt_pk_bf16(x1[0], x1[1]); w.w = cvt_pk_bf16(x1[2], x1[3]);
                    st16_wt(rx, off + bj * HALF * 2, w);
                    if (hr >= 0 && hr < 16384 + 256) st16_wt(rx, ((unsigned)hr * 1024u + (unsigned)col0) * 2u + bj * HALF * 2, w); }
                s += swz_xor<16>(s); s = add_xor32(s);
                if (fq == 0) P[rt * 4 + wc] = s; }
        asm volatile("s_waitcnt lgkmcnt(0)" ::: "memory"); __builtin_amdgcn_s_barrier(); asm volatile("" ::: "memory");
        const int tid = wid * 64 + lane;
        if (tid < 256) { const f32x4 p = *(const PG8_LAS f32x4*)(P + tid * 4); sspo[(size_t)(u.pm * BM + tid) * 4 + u.pn] = (p[0] + p[1]) + (p[2] + p[3]); }
        asm volatile("s_waitcnt lgkmcnt(0)" ::: "memory"); __builtin_amdgcn_s_barrier(); asm volatile("" ::: "memory");
    }
};
template <class Epi, class Sched, bool ALIGN_EPI = false, bool SP2 = false>
__device__ __forceinline__ void gemm_phase(PG8_LAS unsigned char* lds, const Gemm g, const Sched& S, const Epi& E, int wave_id  ) {
    int tid_; asm volatile("v_mbcnt_lo_u32_b32 %0, -1, 0\n\tv_mbcnt_hi_u32_b32 %0, -1, %0" : "=v"(tid_)); tid_ += 64 * wave_id;
    const int tid = tid_, wid = __builtin_amdgcn_readfirstlane(tid >> 6), lane = tid & 63, wr = wid >> 2, wc = wid & 3, fr = lane & 15, fq = lane >> 4;
    const int K = g.K, nt = K / BK;
    unsigned voffA[2], voffB[2];
#pragma unroll
    for (int i = 0; i < 2; ++i) { int R, C; stage_rc(tid * 16 + i * 8192, R, C); const int Rb = Epi::PERM ? ((R & ~31) + perm32(R & 31)) : R;
        voffA[i] = (unsigned)(R * K + C) * 2u; voffB[i] = (unsigned)(Rb * K + C) * 2u; }
    const size_t kstep = (size_t)(BK * 2);
    const size_t hstep = (size_t)HALF * K * 2;
    const size_t tstep = 2 * hstep;
    const unsigned ldsw = (unsigned)wid * 1024u;
    const int aoff = lds_byte(wr * 64 + fr, fq * 8), boff = lds_byte(wc * 32 + fr, fq * 8);
#define PG8_SA(b, h) (((b) * 2 + (h)) * HTB)
#define PG8_SB(b, h) ((4 + (b) * 2 + (h)) * HTB)
#define PG8_STAGE(bufoff, gbase, voff) do { _Pragma("unroll") for (int _i = 0; _i < 2; ++_i) \
        __builtin_amdgcn_global_load_lds((const unsigned*)((const char*)(gbase) + (voff)[_i]), (PG8_LAS unsigned*)(lds + (bufoff) + ldsw + _i * 8192), 16, 0, 0); } while (0)
#define PG8_LDA(dst, b, h) do { _Pragma("unroll") for (int m = 0; m < 4; ++m) _Pragma("unroll") for (int k = 0; k < 2; ++k) dst[m][k] = *(const PG8_LAS bf16x8*)(lds + PG8_SA(b, h) + aoff + m * 2048 + k * 1024); } while (0)
#define PG8_LDB(dst, b, h) do { _Pragma("unroll") for (int n = 0; n < 2; ++n) _Pragma("unroll") for (int k = 0; k < 2; ++k) dst[n][k] = *(const PG8_LAS bf16x8*)(lds + PG8_SB(b, h) + boff + n * 2048 + k * 1024); } while (0)
#define PG8_MMA(ai, bj, At, Bt) do { __builtin_amdgcn_s_setprio(1); _Pragma("unroll") for (int m = 0; m < 4; ++m) _Pragma("unroll") for (int n = 0; n < 2; ++n) _Pragma("unroll") for (int k = 0; k < 2; ++k) \
        acc[ai][bj][m][n] = __builtin_amdgcn_mfma_f32_16x16x32_bf16(Bt[n][k], At[m][k], acc[ai][bj][m][n], 0, 0, 0); __builtin_amdgcn_s_setprio(0); } while (0)
#define PG8_WAIT_V(n) asm volatile("s_waitcnt vmcnt(" #n ")" ::: "memory")
#define PG8_WAIT_L(n) asm volatile("s_waitcnt lgkmcnt(" #n ")" ::: "memory")
#define PG8_BAR __builtin_amdgcn_s_barrier()
#define PG8_SCHED __builtin_amdgcn_sched_barrier(0)
    Unit cur, nxt; int ui = 0;
    if (!S.next(0, cur)) return;
    f32x4 acc[2][2][4][2];
#pragma unroll
    for (int a = 0; a < 2; ++a)
#pragma unroll
        for (int b = 0; b < 2; ++b)
#pragma unroll
            for (int m = 0; m < 4; ++m)
#pragma unroll
                for (int n = 0; n < 2; ++n) acc[a][b][m][n] = (f32x4){0.f, 0.f, 0.f, 0.f};
    bf16x8 At[4][2], B0[2][2], B1[2][2];
    const char* cA = (const char*)g.A + (size_t)cur.pm * tstep; const char* cB = (const char*)g.Bt + (size_t)cur.pn * tstep;
    S.a_ready(cur);
    if constexpr (SP2) {
        PG8_STAGE(PG8_SB(0, 0), cB, voffB); PG8_STAGE(PG8_SB(0, 1), cB + hstep, voffB); PG8_STAGE(PG8_SA(0, 0), cA, voffA); PG8_STAGE(PG8_SA(0, 1), cA + hstep, voffA);
        if (wr == 1) PG8_BAR;
        PG8_WAIT_V(2); PG8_BAR;
        PG8_STAGE(PG8_SB(1, 0), cB + kstep, voffB); PG8_STAGE(PG8_SA(1, 0), cA + kstep, voffA); PG8_STAGE(PG8_SB(1, 1), cB + hstep + kstep, voffB);
        PG8_WAIT_V(6); PG8_BAR;
    } else {
        PG8_STAGE(PG8_SB(0, 0), cB, voffB); PG8_STAGE(PG8_SA(0, 0), cA, voffA); PG8_STAGE(PG8_SB(0, 1), cB + hstep, voffB); PG8_STAGE(PG8_SA(0, 1), cA + hstep, voffA);
        if (wr == 1) PG8_BAR;
        PG8_WAIT_V(4); PG8_BAR;
        PG8_STAGE(PG8_SB(1, 0), cB + kstep, voffB); PG8_STAGE(PG8_SA(1, 0), cA + kstep, voffA); PG8_STAGE(PG8_SB(1, 1), cB + hstep + kstep, voffB);
        PG8_WAIT_V(6); PG8_BAR;
    }
#ifdef DBG_GEMM_T
    volatile PG8_LAS unsigned long long* GT = (volatile PG8_LAS unsigned long long*)(lds + 135488 + 512); const bool gt_on = (blockIdx.x == 0 && tid == 0); unsigned long long gt0 = 0;
#endif
    for (;;) {
#ifdef DBG_GEMM_T
        if (gt_on) gt0 = __builtin_amdgcn_s_memrealtime();
#endif
        const bool has_next = S.next(ui + 1, nxt);
        const char* nA = has_next ? (const char*)g.A + (size_t)nxt.pm * tstep : cA; const char* nB = has_next ? (const char*)g.Bt + (size_t)nxt.pn * tstep : cB;
        for (int t = 0; t < nt; t += 2) {
            const bool last = (t == nt - 2);
            const char* a1 = cA + (size_t)(t + 1) * kstep;
            const char* a2 = last ? nA : cA + (size_t)(t + 2) * kstep; const char* b2 = last ? nB : cB + (size_t)(t + 2) * kstep;
            const char* a3 = a2 + kstep; const char* b3 = b2 + kstep;
            if (last && has_next) S.a_ready(nxt);
            if constexpr (SP2) {
            PG8_LDB(B0, 0, 0); PG8_LDB(B1, 0, 1); PG8_SCHED; PG8_LDA(At, 0, 0); PG8_STAGE(PG8_SA(1, 1), a1 + hstep, voffA);
            PG8_WAIT_V(8); PG8_WAIT_L(0); PG8_BAR; PG8_MMA(0, 0, At, B0); PG8_MMA(0, 1, At, B1); PG8_BAR; PG8_SCHED;
            PG8_LDA(At, 0, 1); PG8_STAGE(PG8_SB(0, 0), b2, voffB); PG8_STAGE(PG8_SB(0, 1), b2 + hstep, voffB); PG8_STAGE(PG8_SA(0, 0), a2, voffA);
            PG8_WAIT_V(8); PG8_WAIT_L(0); PG8_BAR; PG8_MMA(1, 0, At, B0); PG8_MMA(1, 1, At, B1); PG8_BAR; PG8_SCHED;
            PG8_LDB(B0, 1, 0); PG8_LDB(B1, 1, 1); PG8_SCHED; PG8_LDA(At, 1, 0); PG8_STAGE(PG8_SA(0, 1), a2 + hstep, voffA);
            PG8_WAIT_V(8); PG8_WAIT_L(0); PG8_BAR; PG8_MMA(0, 0, At, B0); PG8_MMA(0, 1, At, B1); PG8_BAR; PG8_SCHED;
            PG8_LDA(At, 1, 1); PG8_STAGE(PG8_SB(1, 0), b3, voffB); PG8_STAGE(PG8_SB(1, 1), b3 + hstep, voffB); PG8_STAGE(PG8_SA(1, 0), a3, voffA);
            PG8_WAIT_V(8); PG8_WAIT_L(0); PG8_BAR; PG8_MMA(1, 0, At, B0); PG8_MMA(1, 1, At, B1); PG8_BAR; PG8_SCHED;
            } else {
            PG8_LDB(B0, 0, 0); PG8_SCHED; PG8_LDA(At, 0, 0); PG8_STAGE(PG8_SA(1, 1), a1 + hstep, voffA);
            PG8_WAIT_L(8); PG8_BAR; PG8_WAIT_L(0); PG8_MMA(0, 0, At, B0); PG8_BAR; PG8_SCHED;
            PG8_LDB(B1, 0, 1); PG8_STAGE(PG8_SB(0, 0), b2, voffB);
            PG8_BAR; PG8_WAIT_L(0); PG8_MMA(0, 1, At, B1); PG8_BAR;
            PG8_LDA(At, 0, 1); PG8_STAGE(PG8_SA(0, 0), a2, voffA);
            PG8_BAR; PG8_WAIT_L(0); PG8_MMA(1, 0, At, B0); PG8_BAR; PG8_SCHED;
            PG8_STAGE(PG8_SB(0, 1), b2 + hstep, voffB);
            PG8_WAIT_V(6); PG8_BAR; PG8_MMA(1, 1, At, B1); PG8_BAR;
            PG8_LDB(B0, 1, 0); PG8_SCHED; PG8_LDA(At, 1, 0); PG8_STAGE(PG8_SA(0, 1), a2 + hstep, voffA);
            PG8_WAIT_L(8); PG8_BAR; PG8_WAIT_L(0); PG8_MMA(0, 0, At, B0); PG8_BAR; PG8_SCHED;
            PG8_LDB(B1, 1, 1); PG8_STAGE(PG8_SB(1, 0), b3, voffB);
            PG8_BAR; PG8_WAIT_L(0); PG8_MMA(0, 1, At, B1); PG8_BAR;
            PG8_LDA(At, 1, 1); PG8_STAGE(PG8_SA(1, 0), a3, voffA);
            PG8_BAR; PG8_WAIT_L(0); PG8_MMA(1, 0, At, B0); PG8_BAR; PG8_SCHED;
            PG8_STAGE(PG8_SB(1, 1), b3 + hstep, voffB);
            PG8_WAIT_V(6); PG8_BAR; PG8_MMA(1, 1, At, B1); PG8_BAR;
            }
        }
        if constexpr (ALIGN_EPI) { if (wr == 0) PG8_BAR; }
#ifdef DBG_GEMM_T
        if (gt_on) { const unsigned long long t1 = __builtin_amdgcn_s_memrealtime(); GT[0] += t1 - gt0; gt0 = t1; }
#endif
        if constexpr (!Epi::AFTER_DRAIN) { E(acc, cur, wr, wc, fr, fq); S.done(cur); }
#ifdef DBG_GEMM_T
        if (gt_on) { const unsigned long long t1 = __builtin_amdgcn_s_memrealtime(); GT[1] += t1 - gt0; }
#endif
        if (!has_next) break;
#pragma unroll
        for (int a = 0; a < 2; ++a)
#pragma unroll
            for (int b = 0; b < 2; ++b)
#pragma unroll
                for (int m = 0; m < 4; ++m)
#pragma unroll
                    for (int n = 0; n < 2; ++n) acc[a][b][m][n] = (f32x4){0.f, 0.f, 0.f, 0.f};
        cur = nxt; cA = nA; cB = nB; ++ui;
        if constexpr (ALIGN_EPI) { if (wr == 1) PG8_BAR; }
    }
    PG8_WAIT_V(0);
    if constexpr (!ALIGN_EPI) { if (wr == 0) PG8_BAR; }
    PG8_BAR;
    if constexpr (Epi::AFTER_DRAIN) { E.fused(acc, cur, wr, wc, fr, fq, lds, wid, lane); S.done(cur); }
#undef PG8_SA
#undef PG8_SB
#undef PG8_STAGE
#undef PG8_LDA
#undef PG8_LDB
#undef PG8_MMA
#undef PG8_WAIT_V
#undef PG8_WAIT_L
#undef PG8_BAR
#undef PG8_SCHED
}
}

#ifndef PG8_SP2
#define PG8_SP2 true
#endif
#ifndef PG8_ALIGN
#define PG8_ALIGN true
#endif
#define GAS __attribute__((address_space(1)))
#define LAS __attribute__((address_space(3)))
typedef unsigned short bf16;
typedef unsigned v4u __attribute__((ext_vector_type(4)));
typedef float f32x4 __attribute__((ext_vector_type(4)));
typedef short bf16x8 __attribute__((ext_vector_type(8)));
typedef GAS unsigned gu32;
typedef GAS unsigned long long gu64;
#define RLX_AGENT __ATOMIC_RELAXED, __HIP_MEMORY_SCOPE_AGENT
#define LDS_WAIT() asm volatile("s_waitcnt lgkmcnt(0)" ::: "memory")
#define VM_WAIT() asm volatile("s_waitcnt vmcnt(0)" ::: "memory")
__device__ __forceinline__ unsigned long long rt() { return __builtin_amdgcn_s_memrealtime(); }
__device__ __forceinline__ unsigned f2bf(float f) { unsigned u = __builtin_bit_cast(unsigned, f); return (u + 0x7fffu + ((u >> 16) & 1u)) >> 16; }
__device__ __forceinline__ unsigned pk2(float lo, float hi) { return f2bf(lo) | (f2bf(hi) << 16); }

#define XB_TMO      128
#define XB_XCNT(j)  (256  + 64 * (j))
#define XB_XSUB(j)  (1280 + 64 * (j))
#define XB_XGEN(j)  (2304 + 64 * (j))
#define XB_TOP      3328
#define XB_TOPGEN   3392
#define XCD_BAR_WORDS 3456
#define XB_SPIN_CAP (1u << 18)

__device__ __forceinline__ unsigned xb_ld(unsigned* p)              { return __hip_atomic_load(p, __ATOMIC_RELAXED, __HIP_MEMORY_SCOPE_AGENT); }
__device__ __forceinline__ unsigned xb_add(unsigned* p, unsigned v) { return __hip_atomic_fetch_add(p, v, __ATOMIC_RELAXED, __HIP_MEMORY_SCOPE_AGENT); }
__device__ __forceinline__ unsigned xb_xcc_id() { return (unsigned)__builtin_amdgcn_s_getreg((3 << 11) | 20) & 0xFu; }
#define XB_SPIN(cond, bar) do { unsigned _sp = 0; while (cond) { __builtin_amdgcn_s_sleep(1); \
    if ((++_sp & 255u) == 0u) { if (xb_ld(&(bar)[XB_TMO])) break; if (_sp > XB_SPIN_CAP) { atomicAdd(&(bar)[XB_TMO], 1u); break; } } } } while (0)

struct XcdBarrier {
    unsigned* bar; unsigned x;
    volatile LAS unsigned* st;
};

__device__ __forceinline__ XcdBarrier xcd_barrier_post(unsigned* bar, volatile LAS unsigned* st) {
    XcdBarrier b; b.bar = bar; b.x = xb_xcc_id(); b.st = st;
    if (threadIdx.x == 0) (void)xb_add(&bar[XB_XCNT(b.x)], 1u);
    return b;
}
__device__ __forceinline__ void xcd_barrier_complete(unsigned* bar, unsigned x, unsigned& nloc, unsigned& nx) {
    const unsigned G = gridDim.x * gridDim.y * gridDim.z;
    unsigned sum, cnt, mine, sp = 0u;
    for (;;) {
        sum = 0u; cnt = 0u; mine = 0u;
#pragma unroll
        for (unsigned j = 0; j < 16; ++j) { const unsigned c = xb_ld(&bar[XB_XCNT(j)]); sum += c; cnt += (c > 0u) ? 1u : 0u; }
        mine = xb_ld(&bar[XB_XCNT(x)]);
        if (sum == G) break;
        __builtin_amdgcn_s_sleep(1);
        if ((++sp & 255u) == 0u) { if (xb_ld(&bar[XB_TMO])) break; if (sp > XB_SPIN_CAP) { atomicAdd(&bar[XB_TMO], 1u); break; } }
    }
    nloc = mine > 0u ? mine : 1u; nx = cnt > 0u ? cnt : 1u;
}

__device__ __forceinline__ void xcd_barrier(const XcdBarrier& b) {
    asm volatile("s_waitcnt vmcnt(0)" ::: "memory");
    __syncthreads();
    if (threadIdx.x == 0) {
        unsigned* bar = b.bar;
        __builtin_amdgcn_s_waitcnt(0);
        unsigned nloc = b.st[0], nx = b.st[1];
        if (nloc == 0u) { xcd_barrier_complete(bar, b.x, nloc, nx); b.st[0] = nloc; b.st[1] = nx; }
        const unsigned old = xb_add(&bar[XB_XSUB(b.x)], 1u);
        const unsigned gen = old / nloc;
        if (old + 1u == (gen + 1u) * nloc) {
            __builtin_amdgcn_fence(__ATOMIC_RELEASE, "agent");
            asm volatile("s_waitcnt vmcnt(0)" ::: "memory");
            const unsigned og = xb_add(&bar[XB_TOP], 1u);
            const unsigned tg = og / nx;
            if (og + 1u == (tg + 1u) * nx) xb_add(&bar[XB_TOPGEN], 1u);
            else XB_SPIN(xb_ld(&bar[XB_TOPGEN]) == tg, bar);
            __builtin_amdgcn_fence(__ATOMIC_ACQUIRE, "agent");
            xb_add(&bar[XB_XGEN(b.x)], 1u);
            asm volatile("s_waitcnt vmcnt(0)" ::: "memory");
        } else {
            XB_SPIN(xb_ld(&bar[XB_XGEN(b.x)]) == gen, bar);
            __builtin_amdgcn_fence(__ATOMIC_ACQUIRE, "agent");
            asm volatile("s_waitcnt vmcnt(0)" ::: "memory");
        }
    }
    __syncthreads();
}

namespace sba {
typedef short bf16x8 __attribute__((ext_vector_type(8)));
typedef short s16x4 __attribute__((ext_vector_type(4)));
typedef float f32x16 __attribute__((ext_vector_type(16)));
typedef unsigned u32x4 __attribute__((ext_vector_type(4)));
constexpr int PITCH = DIN, QOFF = 768, KOFF = 1280, VOFF = 1792, MIXOFF = 512;
constexpr int SLOTB = 8192, LDS_K = 0, LDS_V = 2 * SLOTB, LDS_OST = 4 * SLOTB, LDS_FLG = LDS_OST + 8 * 4096, LDS_BYTES_ATT = LDS_FLG + 64;
constexpr float CARRY_ZERO = 152.0f;
__device__ __forceinline__ int crow(int r, int hi) { return (r & 3) + 8 * (r >> 2) + 4 * hi; }
__device__ __forceinline__ void glds16(const void* gsrc, unsigned lds_dst) { unsigned keep;
    asm volatile("s_mov_b32 %0, m0\n\ts_mov_b32 m0, %2\n\ts_nop 0\n\tglobal_load_lds_dwordx4 %1, off\n\ts_mov_b32 m0, %0" : "=&s"(keep) : "v"(gsrc), "s"(lds_dst) : "memory"); }
typedef float f32x2_t __attribute__((ext_vector_type(2))); typedef __bf16 bf16x2_t __attribute__((ext_vector_type(2)));
__device__ __forceinline__ unsigned cvtpk_s(float lo, float hi) { f32x2_t v = {lo, hi}; bf16x2_t b = __builtin_convertvector(v, bf16x2_t); return __builtin_bit_cast(unsigned, b); }
#define SBA_WAIT_BAR() asm volatile("s_waitcnt vmcnt(0) lgkmcnt(0)\n\ts_barrier" ::: "memory")
#define SBA_SBAR() __builtin_amdgcn_sched_barrier(0)
typedef __attribute__((address_space(3))) const char* lds_cptr;
__device__ __forceinline__ void kload8(bf16x8* kf, lds_cptr kp) {
    kf[0] = *(const __attribute__((address_space(3))) bf16x8*)(kp);        kf[1] = *(const __attribute__((address_space(3))) bf16x8*)(kp + 512);
    kf[2] = *(const __attribute__((address_space(3))) bf16x8*)(kp + 2048); kf[3] = *(const __attribute__((address_space(3))) bf16x8*)(kp + 2560);
    kf[4] = *(const __attribute__((address_space(3))) bf16x8*)(kp + 4096); kf[5] = *(const __attribute__((address_space(3))) bf16x8*)(kp + 4608);
    kf[6] = *(const __attribute__((address_space(3))) bf16x8*)(kp + 6144); kf[7] = *(const __attribute__((address_space(3))) bf16x8*)(kp + 6656);
}
#define SBA_MFMA(a, b, c) __builtin_amdgcn_mfma_f32_32x32x16_bf16((a), (b), (c), 0, 0, 0)
__device__ __forceinline__ void pv(f32x16* o, int vb, bf16x8 pa0, bf16x8 pa1, bf16x8 pa2, bf16x8 pa3) {
#pragma unroll
    for (int d0 = 0; d0 < 2; ++d0) { s16x4 lo[4], hi[4];
#pragma unroll
        for (int ks = 0; ks < 4; ++ks) {
            asm volatile("ds_read_b64_tr_b16 %0,%1 offset:%c2" : "=&v"(lo[ks]) : "v"(vb), "i"(d0 * 4096 + ks * 1024) : "memory");
            asm volatile("ds_read_b64_tr_b16 %0,%1 offset:%c2" : "=&v"(hi[ks]) : "v"(vb), "i"(d0 * 4096 + ks * 1024 + 512) : "memory"); }
        asm volatile("s_waitcnt lgkmcnt(0)" ::: "memory"); SBA_SBAR();
#define SBA_PK(k) (bf16x8){lo[k][0], lo[k][1], lo[k][2], lo[k][3], hi[k][0], hi[k][1], hi[k][2], hi[k][3]}
        o[d0] = SBA_MFMA(pa0, SBA_PK(0), o[d0]); o[d0] = SBA_MFMA(pa1, SBA_PK(1), o[d0]); o[d0] = SBA_MFMA(pa2, SBA_PK(2), o[d0]); o[d0] = SBA_MFMA(pa3, SBA_PK(3), o[d0]);
#undef SBA_PK
    }
}
__device__ __forceinline__ bf16x8 pack8(const f32x16& x, int b) { u32x4 p; p[0] = cvtpk_s(x[b], x[b + 1]); p[1] = cvtpk_s(x[b + 2], x[b + 3]); p[2] = cvtpk_s(x[b + 4], x[b + 5]); p[3] = cvtpk_s(x[b + 6], x[b + 7]); return __builtin_bit_cast(bf16x8, p); }

__device__ __forceinline__ void attn_unit(int b, int h, int qb, const unsigned short* PROJ, unsigned short* MIX, char* shm, int wid, int lane) {
    const int r32 = lane & 31, hi = lane >> 5;
    const long rowbase = (long)b * SEQ; const int q0 = qb * 256;
    const unsigned short* Qw = PROJ + (rowbase + q0 + wid * 32) * PITCH + QOFF + h * 64;
    const unsigned short* Kh = PROJ + rowbase * PITCH + KOFF + h * 64; const unsigned short* Vh = PROJ + rowbase * PITCH + VOFF + h * 64;
    const unsigned lds0 = (unsigned)(uintptr_t)shm;
    const unsigned short* ksrc = Kh + (long)lane * PITCH + wid * 8;
    const unsigned short* vsrc = Vh + (long)(16 * (wid & 3) + (lane >> 2)) * PITCH + (wid >> 2) * 32 + (lane & 3) * 8;
    const unsigned kdst = lds0 + LDS_K + wid * 1024, vdst = lds0 + LDS_V + wid * 1024;
#define SBA_DMA(t, slot) do { glds16(ksrc + (long)(t) * 64 * PITCH, (unsigned)__builtin_amdgcn_readfirstlane(kdst + (slot))); glds16(vsrc + (long)(t) * 64 * PITCH, (unsigned)__builtin_amdgcn_readfirstlane(vdst + (slot))); } while (0)
    const int vb0 = (int)(lds0 + LDS_V) + ((lane >> 4) & 1) * 32 + (lane & 3) * 8 + (4 * hi + ((lane & 15) >> 2)) * 64;
    const lds_cptr kp0 = (lds_cptr)shm + LDS_K + hi * 1024 + r32 * 16;
    const int NT = 4 * (qb + 1);
    SBA_DMA(NT - 1, 0);
    bf16x8 qr[4];
#pragma unroll
    for (int d0 = 0; d0 < 4; ++d0) qr[d0] = *reinterpret_cast<const bf16x8*>(&Qw[(long)r32 * PITCH + d0 * 16 + hi * 8]);
    bf16x8 U0, U1, J;
#pragma unroll
    for (int j = 0; j < 8; ++j) { const int k0 = 8 * (j >> 2) + 4 * hi + (j & 3); U0[j] = (k0 >= r32) ? (short)0x3F80 : (short)0; U1[j] = (16 + k0 >= r32) ? (short)0x3F80 : (short)0; J[j] = (short)0x3F80; }
    f32x16 C, o[2];
#pragma unroll
    for (int r = 0; r < 16; ++r) { C[r] = 0.f; o[0][r] = 0.f; o[1][r] = 0.f; }
    const int qrel = wid * 32 + r32;
    volatile __attribute__((address_space(3))) int* flg = (volatile __attribute__((address_space(3))) int*)((lds_cptr)shm + LDS_FLG);
    if (lane == 0) flg[wid] = 0x7fffffff;
    bool wdone = false;
    SBA_WAIT_BAR();
    for (int i = 0; i < NT; ++i) {
        const int t = NT - 1 - i, slot = (i & 1) * SLOTB, jb = t - 4 * qb;
        if (i + 1 < NT) SBA_DMA(t - 1, slot ^ SLOTB);
        if (!wdone && !(jb >= 0 && 2 * jb > wid)) {
            bf16x8 kf[8]; kload8(kf, kp0 + slot);
            f32x16 z0, z1;
#pragma unroll
            for (int r = 0; r < 16; ++r) { z0[r] = 0.f; z1[r] = 0.f; }
#pragma unroll
            for (int s = 0; s < 4; ++s) { z0 = SBA_MFMA(kf[2 * s], qr[s], z0); z1 = SBA_MFMA(kf[2 * s + 1], qr[s], z1); }
            if (jb >= 0) { const int kb = 64 * jb + 4 * hi;
#pragma unroll
                for (int r = 0; r < 16; ++r) { const int kv = kb + (r & 3) + 8 * (r >> 2); if (kv >= qrel) z0[r] = -INFINITY; if (kv + 32 >= qrel) z1[r] = -INFINITY; } }
            f32x16 s0, s1;
#pragma unroll
            for (int r = 0; r < 16; ++r) { s0[r] = fmaxf(z0[r], 0.f) + __builtin_amdgcn_logf(1.0f + __builtin_amdgcn_exp2f(-fabsf(z0[r]))); s1[r] = fmaxf(z1[r], 0.f) + __builtin_amdgcn_logf(1.0f + __builtin_amdgcn_exp2f(-fabsf(z1[r]))); }
            const bf16x8 f00 = pack8(s0, 0), f01 = pack8(s0, 8), f10 = pack8(s1, 0), f11 = pack8(s1, 8);
            f32x16 Dv = SBA_MFMA(J, f10, C); Dv = SBA_MFMA(J, f11, Dv);
            f32x16 c1 = SBA_MFMA(U0, f10, C); c1 = SBA_MFMA(U1, f11, c1);
            f32x16 c0 = SBA_MFMA(U0, f00, Dv); c0 = SBA_MFMA(U1, f01, c0);
            C = SBA_MFMA(J, f00, Dv); C = SBA_MFMA(J, f01, C);
#pragma unroll
            for (int r = 0; r < 16; ++r) { z0[r] = __builtin_amdgcn_exp2f(z0[r] - c0[r]); z1[r] = __builtin_amdgcn_exp2f(z1[r] - c1[r]); }
            const bf16x8 p0 = pack8(z0, 0), p1 = pack8(z0, 8), p2 = pack8(z1, 0), p3 = pack8(z1, 8);
            pv(o, vb0 + slot, p0, p1, p2, p3);
            if (__all(C[0] >= CARRY_ZERO)) { wdone = true; if (lane == 0) flg[wid] = i; }
        }
        SBA_WAIT_BAR();
        { int m = flg[0];
#pragma unroll
          for (int w = 1; w < 8; ++w) { const int f = flg[w]; m = f > m ? f : m; }
          if (__builtin_amdgcn_readfirstlane(m) <= i) break; }
    }
    { unsigned short* stg = (unsigned short*)(shm + LDS_OST) + wid * 2048;
#pragma unroll
      for (int r = 0; r < 16; ++r) { const int orow = crow(r, hi);
#pragma unroll
          for (int d0 = 0; d0 < 2; ++d0) stg[orow * 64 + d0 * 32 + r32] = (unsigned short)(cvtpk_s(o[d0][r], 0.f) & 0xffffu); }
      asm volatile("s_waitcnt lgkmcnt(0)" ::: "memory");
      const __amdgpu_buffer_rsrc_t rmix = __builtin_amdgcn_make_buffer_rsrc((void*)MIX, (short)0, (int)(16384u * 1024u * 2u), 0x00020000);
#pragma unroll
      for (int i = 0; i < 4; ++i) { const int row = i * 8 + (lane >> 3), ch = lane & 7; const u32x4 v = *(const u32x4*)(stg + row * 64 + ch * 8); __builtin_amdgcn_raw_buffer_store_b128(v, rmix, (int)(((rowbase + q0 + wid * 32 + row) * D + MIXOFF + h * 64 + ch * 8) * 2), 0, 16); } }
    asm volatile("s_waitcnt lgkmcnt(0)\n\ts_barrier" ::: "memory");
#undef SBA_DMA
}
}

constexpr int NWAVES = 8;
#ifndef MK_N_LAUNCHES
#define MK_N_LAUNCHES 1
#endif
constexpr int N_PHASES = 12;
constexpr size_t MiB = 1u << 20;
constexpr size_t WS_CTL = 0, CTL_ZERO_BYTES = 64 * 1024;
constexpr int CW_BAR = 4096;
constexpr size_t WS_SSPA = 1 * MiB, WS_SSPB = WS_SSPA + 256 * 1024, WS_BO = WS_SSPB + 256 * 1024;
constexpr size_t WS_WIN = 2 * MiB, WS_WOUT = 11 * MiB, WS_WUP = 15 * MiB, WS_WDN = 37 * MiB;
constexpr size_t WS_XB = 48 * MiB;
constexpr size_t WS_R = 81 * MiB, WS_PROJ = WS_R, WS_MIX = WS_R + 72 * MiB, WS_H = WS_R, WS_END = WS_R + 104 * MiB;
static_assert(WS_XB + (size_t)(M + 256) * D * 2 <= WS_R && WS_END <= 256 * MiB && WS_H + (size_t)M * DFF * 2 <= WS_END && WS_MIX + (size_t)M * D * 2 <= WS_END, "ws map");
constexpr int RING_OFF = 0, RING_BYTES = 131072, XL_OFF = RING_BYTES, LDSCTL_OFF = XL_OFF + 4096, MISC_OFF = LDSCTL_OFF + 320, LDS_BYTES = 147456;

struct Frame { LAS unsigned char* lds; volatile LAS unsigned* MISC; gu32* ctl; int tid, lane, wave, vcu, G; };
__device__ __forceinline__ float wave_sum(float v) { return pg8::wave_sum_all(v); }
__device__ __forceinline__ float bf2f(unsigned short b) { return __builtin_bit_cast(float, (unsigned)b << 16); }
__device__ __forceinline__ int map_in(int n) { const int t = n >> 8, j = n & 255; return (t < 2) ? ((j < 128) ? 128 * t + j : 256 + 128 * t + (j - 128)) : n; }
__device__ __forceinline__ int map_up(int n) { const int t = n >> 8, j = n & 255; return (j < 128) ? 128 * t + j : DFF + 128 * t + (j - 128); }

__device__ __forceinline__ void p0_transpose_item(const float* W, int K, int N, const float* g, bf16* WT, int src0, int n0, int k0, LAS float* scr, int lane, float cs = 1.0f) {
    float wv[32];
#pragma unroll
    for (int i = 0; i < 32; ++i) wv[i] = W[(size_t)(k0 + 2 * i + (lane >> 5)) * N + src0 + (lane & 31)];
    float gv[32];
    if (g) {
#pragma unroll
        for (int i = 0; i < 32; ++i) gv[i] = g[k0 + 2 * i + (lane >> 5)];
    } else {
#pragma unroll
        for (int i = 0; i < 32; ++i) gv[i] = 1.0f; }
#pragma unroll
    for (int i = 0; i < 32; ++i) { const int kk = 2 * i + (lane >> 5); scr[kk * 33 + (lane & 31)] = wv[i] * gv[i] * cs; }
    LDS_WAIT(); asm volatile("" ::: "memory");
    const int c = lane & 7;
#pragma unroll
    for (int j = 0; j < 4; ++j) { const int n = (lane >> 3) + 8 * j; const LAS float* s = scr + (8 * c) * 33 + n;
        v4u o; o.x = pk2(s[0 * 33], s[1 * 33]); o.y = pk2(s[2 * 33], s[3 * 33]); o.z = pk2(s[4 * 33], s[5 * 33]); o.w = pk2(s[6 * 33], s[7 * 33]);
        *(v4u*)(WT + (size_t)(n0 + n) * K + k0 + 8 * c) = o; }
    LDS_WAIT(); asm volatile("" ::: "memory");
}
struct Ptrs {
    const float *x, *norm1_g, *w_in, *cdw_w, *cdw_b, *cln_g, *cln_b, *cpw_w, *cpw_b, *pool_w, *pool_scale, *w_out, *norm2_g, *ffn_up, *fdw_w, *fdw_b, *ffn_down, *final_g;
    float* out; float *SSPA, *SSPB, *BO; bf16 *WIN, *WOUT, *WUP, *WDN, *XB, *PROJ, *MIX, *H;
};
__device__ __forceinline__ void p0_prologue(Frame& F, const Ptrs& P) {
    LAS float* scr = (LAS float*)(F.lds + RING_OFF + F.wave * 16384);
    const int gw = F.vcu * NWAVES + F.wave, NGW = F.G * NWAVES, lane = F.lane;
    constexpr int I_IN = 16 * 72, I_UP = 16 * 176, I_DN = 44 * 32, I_L = I_IN + I_UP + I_DN;
    for (int it = gw; it < DEPTH * I_L; it += NGW) {
        const int l = it / I_L; int r = it % I_L;
        if (r < I_IN) { const int kb = r / 72, nb = r % 72; p0_transpose_item(P.w_in + (size_t)l * D * DIN, D, DIN, P.norm1_g + l * D, P.WIN + (size_t)l * DIN * D, map_in(32 * nb), 32 * nb, 64 * kb, scr, lane, (32 * nb >= 768 && 32 * nb < 1280) ? 0.125f * 1.4426950408889634f : 1.0f); continue; } r -= I_IN;
        if (r < I_UP) { const int kb = r / 176, nb = r % 176; p0_transpose_item(P.ffn_up + (size_t)l * D * DUP, D, DUP, P.norm2_g + l * D, P.WUP + (size_t)l * DUP * D, map_up(32 * nb), 32 * nb, 64 * kb, scr, lane); continue; } r -= I_UP;
        { const int kb = r / 32, nb = r % 32; p0_transpose_item(P.ffn_down + (size_t)l * DFF * D, DFF, D, nullptr, P.WDN + (size_t)l * D * DFF, 32 * nb, 32 * nb, 64 * kb, scr, lane); }
    }
    for (int it = gw; it < DEPTH * 64 * 16; it += NGW) {
        const int l = it / 1024, kg = (it % 1024) / 16, nt = it % 16, k0 = 4 * kg, n = 64 * nt + lane;
        const float* wo = P.w_out + (size_t)l * D * D + n; const float* pw = P.cpw_w + (size_t)l * DCONV * DCONV + (size_t)k0 * DCONV; float acc[4] = {0.f, 0.f, 0.f, 0.f};
        for (int j0 = 0; j0 < 256; j0 += 32) { float wv[32];
#pragma unroll
            for (int u = 0; u < 32; ++u) wv[u] = wo[(size_t)(j0 + u) * D];
#pragma unroll
            for (int u = 0; u < 32; ++u)
#pragma unroll
                for (int i = 0; i < 4; ++i) acc[i] += pw[i * DCONV + j0 + u] * wv[u]; }
        *(unsigned long long*)(P.WOUT + (size_t)l * D * D + (size_t)n * D + k0) = (unsigned long long)pk2(acc[0], acc[1]) | ((unsigned long long)pk2(acc[2], acc[3]) << 32);
    }
    for (int it = gw; it < DEPTH * 64 * 16; it += NGW) {
        const int l = it / 1024, kg = (it % 1024) / 16, nt = it % 16, k0 = 256 + 4 * kg, n = 64 * nt + lane;
        const int g = (k0 - 256) >> 6, c0 = (k0 - 256) & 63; const float* pw = P.pool_w + (size_t)l * 4 * 64 * 64 + (size_t)(g * 64 + c0) * 64; const float* ps = P.pool_scale + l * DPOOL + 64 * g;
        const float* wo = P.w_out + (size_t)l * D * D + (size_t)(256 + 64 * g) * D + n; float acc[4] = {0.f, 0.f, 0.f, 0.f};
        for (int d0 = 0; d0 < 64; d0 += 8) { float wv[8];
#pragma unroll
            for (int u = 0; u < 8; ++u) wv[u] = ps[d0 + u] * wo[(size_t)(d0 + u) * D];
#pragma unroll
            for (int u = 0; u < 8; ++u)
#pragma unroll
                for (int i = 0; i < 4; ++i) acc[i] += pw[i * 64 + d0 + u] * wv[u]; }
        *(unsigned long long*)(P.WOUT + (size_t)l * D * D + (size_t)n * D + k0) = (unsigned long long)pk2(acc[0], acc[1]) | ((unsigned long long)pk2(acc[2], acc[3]) << 32);
    }
    for (int it = gw; it < DEPTH * 64 * 16; it += NGW) {
        const int l = it / 1024, kg = (it % 1024) / 16, nt = it % 16, k0 = 512 + 8 * kg, n = 64 * nt + lane;
        const float* wo = P.w_out + (size_t)l * D * D + n; float acc[8];
#pragma unroll
        for (int i = 0; i < 8; ++i) acc[i] = wo[(size_t)(k0 + i) * D];
        v4u o; o.x = pk2(acc[0], acc[1]); o.y = pk2(acc[2], acc[3]); o.z = pk2(acc[4], acc[5]); o.w = pk2(acc[6], acc[7]);
        *(v4u*)(P.WOUT + (size_t)l * D * D + (size_t)n * D + k0) = o;
    }
    for (int it = gw; it < DEPTH * 16; it += NGW) { const int l = it / 16, n = 64 * (it % 16) + lane; float acc = 0.f;
        for (int j = 0; j < 256; ++j) acc += P.cpw_b[l * DCONV + j] * P.w_out[(size_t)l * D * D + (size_t)j * D + n];
        P.BO[l * D + n] = acc; }
    for (int r0 = 4 * gw; r0 < M; r0 += 4 * NGW) {
        f32x4 v[4][4];
#pragma unroll
        for (int q = 0; q < 4; ++q)
#pragma unroll
            for (int j = 0; j < 4; ++j) v[q][j] = ((const f32x4*)(P.x + (size_t)(r0 + q) * D) + lane)[64 * j];
#pragma unroll
        for (int q = 0; q < 4; ++q) { float s = 0.f; unsigned long long* o = (unsigned long long*)(P.XB + (size_t)(r0 + q) * D) + lane;
#pragma unroll
            for (int j = 0; j < 4; ++j) { const f32x4 t = v[q][j]; s += (t.x * t.x + t.y * t.y) + (t.z * t.z + t.w * t.w); o[64 * j] = (unsigned long long)pk2(t.x, t.y) | ((unsigned long long)pk2(t.z, t.w) << 32); }
            s = wave_sum(s); if (lane == 0) *(f32x4*)(P.SSPB + (size_t)(r0 + q) * 4) = (f32x4){s, 0.f, 0.f, 0.f}; }
    }
}
__device__ __forceinline__ void convpool_unit(Frame& F, const Ptrs& P, int l, int t0) {
    bf16* Ul = (bf16*)(F.lds + RING_OFF); float* Y = (float*)(F.lds + RING_OFF + 94 * 256 * 2);
    LAS bf16* UlL = (LAS bf16*)(F.lds + RING_OFF); LAS float* YL = (LAS float*)(F.lds + RING_OFF + 94 * 256 * 2); (void)Ul; (void)Y;
    const int tid = F.tid, tl = t0 % SEQ; const bf16* PR = P.PROJ;
    { v4u av[6], gv[6];
#pragma unroll
      for (int k = 0; k < 6; ++k) { const int i = tid + 512 * k; const int r = i >> 5, ch = i & 31, c0 = ch * 8, tt = c0 >> 7, j = c0 & 127; const int tok = tl - 30 + r;
          const int rr = (r > 93 ? 93 : r), rowc = (tok >= 0) ? (t0 - 30 + rr) : t0;
          const bf16* rp = PR + (size_t)rowc * DIN + 256 * tt + j; av[k] = *(const v4u*)rp; gv[k] = *(const v4u*)(rp + 128);
          if (tok < 0) { av[k] = (v4u){0u, 0u, 0u, 0u}; gv[k] = av[k]; } }
#pragma unroll
      for (int k = 0; k < 6; ++k) { const int i = tid + 512 * k; const int r = i >> 5, ch = i & 31, c0 = ch * 8; unsigned ov[4];
#pragma unroll
          for (int q = 0; q < 4; ++q) { const unsigned aw = av[k][q], gw_ = gv[k][q];
              const float a0 = bf2f((unsigned short)(aw & 0xffff)), a1 = bf2f((unsigned short)(aw >> 16)), g0 = bf2f((unsigned short)(gw_ & 0xffff)), g1 = bf2f((unsigned short)(gw_ >> 16));
              ov[q] = pk2(a0 / (1.0f + __expf(-g0)), a1 / (1.0f + __expf(-g1))); }
          if (i < 94 * 32) *(LAS v4u*)(UlL + r * 256 + c0) = (v4u){ov[0], ov[1], ov[2], ov[3]}; } }
    __syncthreads();
    const int c = tid & 255, half = tid >> 8;
    const int tb = tl + half * 32; const bf16* pc = PR + 512 + c; unsigned short pv_[47];
#pragma unroll
    for (int k = 0; k < 47; ++k) { const int tok = tb - 15 + k; pv_[k] = pc[(size_t)(t0 + half * 32 + (tok >= 0 ? k - 15 : 0)) * DIN]; }
#pragma unroll
    for (int k = 0; k < 15; ++k) if (tb - 15 + k < 0) pv_[k] = (unsigned short)0;
    { const float* dw_w = P.cdw_w + (size_t)l * CONVK * DCONV; float w[CONVK];
#pragma unroll
      for (int i = 0; i < CONVK; ++i) w[i] = dw_w[i * DCONV + c];
      const float bb = P.cdw_b[l * DCONV + c];
#pragma unroll 1
      for (int g = 0; g < 2; ++g) { const int tbq = half * 32 + g * 16; float in[46];
#pragma unroll
          for (int i = 0; i < 46; ++i) in[i] = bf2f(UlL[(tbq + i) * 256 + c]);
#pragma unroll
          for (int q = 0; q < 16; ++q) { float acc = bb;
#pragma unroll
              for (int i = 0; i < CONVK; ++i) acc += w[i] * in[q + i];
              YL[(tbq + q) * 256 + c] = acc; } } }
    __syncthreads();
    { const int wv = F.wave, lane = F.lane; const f32x4 gg = ((const f32x4*)(P.cln_g + l * DCONV))[lane], bbv = ((const f32x4*)(P.cln_b + l * DCONV))[lane];
      f32x4 y[8]; float s1[8], s2[8];
#pragma unroll
      for (int q = 0; q < 8; ++q) { y[q] = ((const LAS f32x4*)(YL + (wv * 8 + q) * 256))[lane]; s1[q] = (y[q].x + y[q].y) + (y[q].z + y[q].w); }
#pragma unroll
      for (int q = 0; q < 8; ++q) s1[q] += pg8::swz_xor<1>(s1[q]);
#pragma unroll
      for (int q = 0; q < 8; ++q) s1[q] += pg8::swz_xor<2>(s1[q]);
#pragma unroll
      for (int q = 0; q < 8; ++q) s1[q] += pg8::swz_xor<4>(s1[q]);
#pragma unroll
      for (int q = 0; q < 8; ++q) s1[q] += pg8::swz_xor<8>(s1[q]);
#pragma unroll
      for (int q = 0; q < 8; ++q) s1[q] += pg8::swz_xor<16>(s1[q]);
#pragma unroll
      for (int q = 0; q < 8; ++q) { const float mu = pg8::add_xor32(s1[q]) * (1.0f / 256.0f); y[q] = y[q] - mu; s2[q] = (y[q].x * y[q].x + y[q].y * y[q].y) + (y[q].z * y[q].z + y[q].w * y[q].w); }
#pragma unroll
      for (int q = 0; q < 8; ++q) s2[q] += pg8::swz_xor<1>(s2[q]);
#pragma unroll
      for (int q = 0; q < 8; ++q) s2[q] += pg8::swz_xor<2>(s2[q]);
#pragma unroll
      for (int q = 0; q < 8; ++q) s2[q] += pg8::swz_xor<4>(s2[q]);
#pragma unroll
      for (int q = 0; q < 8; ++q) s2[q] += pg8::swz_xor<8>(s2[q]);
#pragma unroll
      for (int q = 0; q < 8; ++q) s2[q] += pg8::swz_xor<16>(s2[q]);
#pragma unroll
      for (int q = 0; q < 8; ++q) { const float rs = 1.0f / sqrtf(pg8::add_xor32(s2[q]) * (1.0f / 256.0f) + EPS);
          f32x4 z = y[q] * rs * gg + bbv; z.x = z.x / (1.0f + __expf(-z.x)); z.y = z.y / (1.0f + __expf(-z.y)); z.z = z.z / (1.0f + __expf(-z.z)); z.w = z.w / (1.0f + __expf(-z.w));
          *(unsigned long long*)(P.MIX + (size_t)(t0 + wv * 8 + q) * D + 4 * lane) = (unsigned long long)pk2(z.x, z.y) | ((unsigned long long)pk2(z.z, z.w) << 32); } }
    { const int win = 2 << (c >> 6);
#pragma unroll
      for (int q = 0; q < 32; ++q) { float s = 0.f;
#pragma unroll
          for (int j = 0; j < 16; ++j) s += (j < win) ? bf2f(pv_[15 + q - j]) : 0.f;
          const int tloc = tb + q; const int cnt = (tloc + 1 < win) ? tloc + 1 : win;
          P.MIX[(size_t)(t0 + half * 32 + q) * D + 256 + c] = (bf16)f2bf(s / (float)cnt - bf2f(pv_[15 + q])); } }
    __syncthreads();
}
__device__ __forceinline__ void mixers_phase(Frame& F, const Ptrs& P, int l) {
#ifdef DBG_MIX_T
    volatile LAS unsigned long long* TSm = (volatile LAS unsigned long long*)(F.lds + MISC_OFF + 256); if (blockIdx.x == 0 && F.tid == 0) TSm[38] = rt();
#endif
    for (int u = F.vcu; u < M / 64; u += F.G) convpool_unit(F, P, l, 64 * u);
#ifdef DBG_MIX_T
    if (blockIdx.x == 0 && F.tid == 0) { const unsigned long long t1 = rt(); TSm[36] += t1 - TSm[38]; TSm[38] = t1; }
#endif
    for (int k = 0; k < 2; ++k) for (int c = F.vcu; c < 256; c += F.G) { const int bh = c >> 2, j = c & 3, qb = k ? 7 - j : j;
        sba::attn_unit(bh >> 3, bh & 7, qb, P.PROJ, P.MIX, (char*)F.lds + RING_OFF, F.wave, F.lane); }
#ifdef DBG_MIX_T
    if (blockIdx.x == 0 && F.tid == 0) { TSm[37] += rt() - TSm[38]; }
#endif
}
__device__ __forceinline__ void final_phase(Frame& F, const Ptrs& P) {
    const int gw = F.vcu * NWAVES + F.wave, NGW = F.G * NWAVES, lane = F.lane;
    for (int r0 = 2 * gw; r0 < M; r0 += 2 * NGW) {
        v4u xb[2][2]; float r[2];
#pragma unroll
        for (int q = 0; q < 2; ++q) { xb[q][0] = ((const v4u*)(P.XB + (size_t)(r0 + q) * D))[lane]; xb[q][1] = ((const v4u*)(P.XB + (size_t)(r0 + q) * D))[64 + lane]; r[q] = pg8::rs_from_ssp(P.SSPB, r0 + q); }
#pragma unroll
        for (int q = 0; q < 2; ++q)
#pragma unroll
            for (int hf = 0; hf < 2; ++hf) { const f32x4* gr = (const f32x4*)(P.final_g + 512 * hf + 8 * lane); f32x4* o = (f32x4*)(P.out + (size_t)(r0 + q) * D + 512 * hf + 8 * lane); const v4u w = xb[q][hf];
                f32x4 a, b2; a[0] = __builtin_bit_cast(float, w[0] << 16); a[1] = __builtin_bit_cast(float, w[0] & 0xffff0000u); a[2] = __builtin_bit_cast(float, w[1] << 16); a[3] = __builtin_bit_cast(float, w[1] & 0xffff0000u);
                b2[0] = __builtin_bit_cast(float, w[2] << 16); b2[1] = __builtin_bit_cast(float, w[2] & 0xffff0000u); b2[2] = __builtin_bit_cast(float, w[3] << 16); b2[3] = __builtin_bit_cast(float, w[3] & 0xffff0000u);
                o[0] = a * r[q] * gr[0]; o[1] = b2 * r[q] * gr[1]; }
    }
}

#define MKP() Ptrs P; do { unsigned char* ws = args.ws; asm volatile("" : "+s"(ws)); P.x = args.in[0]; P.norm1_g = args.in[1]; P.w_in = args.in[2]; P.cdw_w = args.in[3]; P.cdw_b = args.in[4]; P.cln_g = args.in[5]; P.cln_b = args.in[6]; P.cpw_w = args.in[7]; P.cpw_b = args.in[8]; P.pool_w = args.in[9]; P.pool_scale = args.in[10]; P.w_out = args.in[11]; P.norm2_g = args.in[12]; P.ffn_up = args.in[13]; P.fdw_w = args.in[14]; P.fdw_b = args.in[15]; P.ffn_down = args.in[16]; P.final_g = args.in[17]; P.out = args.out; P.SSPA = (float*)(ws + WS_SSPA); P.SSPB = (float*)(ws + WS_SSPB); P.BO = (float*)(ws + WS_BO); P.WIN = (bf16*)(ws + WS_WIN); P.WOUT = (bf16*)(ws + WS_WOUT); P.WUP = (bf16*)(ws + WS_WUP); P.WDN = (bf16*)(ws + WS_WDN); P.XB = (bf16*)(ws + WS_XB); P.PROJ = (bf16*)(ws + WS_PROJ); P.MIX = (bf16*)(ws + WS_MIX); P.H = (bf16*)(ws + WS_H); } while (0)
struct Args { const float* in[18]; float* out; unsigned char* ws; int ph_lo, ph_hi; };
__global__ void __launch_bounds__(NWAVES * 64, 2) mega_fwd(Args args) {
    extern __shared__ __attribute__((aligned(16))) unsigned char lds[];
    Frame F;
    F.lds = (LAS unsigned char*)lds; F.MISC = (volatile LAS unsigned*)(F.lds + MISC_OFF);
    F.tid = threadIdx.x; F.lane = F.tid & 63; F.wave = __builtin_amdgcn_readfirstlane(F.tid >> 6);
    F.G = gridDim.x; { const int bx = blockIdx.x; F.vcu = (F.G % 8 == 0) ? (bx % 8) * (F.G / 8) + bx / 8 : bx; }
    F.ctl = (gu32*)(args.ws + WS_CTL);
    for (int u = F.tid; u < (LDS_BYTES - LDSCTL_OFF) / 4; u += NWAVES * 64) ((LAS unsigned*)(F.lds + LDSCTL_OFF))[u] = 0u;
    __syncthreads();
    const int lo = args.ph_lo, hi = args.ph_hi;
    const bool use_bar = (hi - lo) > 1;
    XcdBarrier bar; bar.bar = (unsigned*)(F.ctl + CW_BAR); bar.x = 0; bar.st = nullptr;
    if (use_bar) bar = xcd_barrier_post((unsigned*)(F.ctl + CW_BAR), F.MISC + 8);
#define REFRESH() do { int l_; asm volatile("v_mbcnt_lo_u32_b32 %0, -1, 0\n\tv_mbcnt_hi_u32_b32 %0, -1, %0" : "=v"(l_)); F.lane = l_; F.tid = 64 * F.wave + l_; } while (0)
#define LAUNDER_S(v) asm volatile("" : "+s"(v))
#ifdef DBG_TIMING
#ifndef DBG_GT_ST
#define DBG_GT_ST 3
#endif
    volatile LAS unsigned long long* TS = (volatile LAS unsigned long long*)(F.lds + MISC_OFF + 256);
    const bool stamper = (blockIdx.x == 0 && threadIdx.x == 0);
    if (stamper) { TS[0] = rt(); TS[16] = 0; TS[32] = 0; TS[33] = 0; TS[34] = 0; TS[35] = 0; TS[36] = 0; TS[37] = 0; }
#endif
#pragma nounroll
    for (int ph_ = lo; ph_ < hi; ++ph_) {
        int ph = ph_; LAUNDER_S(ph);
        const int l = (ph - 1) / 5, st = (ph == 0) ? -1 : (ph == N_PHASES - 1 ? 5 : (ph - 1) % 5);
        int bx = (int)blockIdx.x; LAUNDER_S(bx);
        MKP();
        if (st == -1) { }
        else if (st == 0) {
            pg8::Gemm g{P.XB, P.WIN + (size_t)l * DIN * D, M, DIN, D}; pg8::StaticOrder S; S.init(M, DIN, F.G, bx);
            pg8::EpiProj E{P.PROJ, DIN, P.SSPB};
            pg8::gemm_phase<pg8::EpiProj, pg8::StaticOrder, PG8_ALIGN, PG8_SP2>(F.lds + RING_OFF, g, S, E, F.wave); }
        else if (st == 1) { REFRESH(); mixers_phase(F, P, l); }
        else if (st == 2 || st == 4) {
            const bool o = (st == 2);
            pg8::Gemm g{o ? P.MIX : P.H, o ? P.WOUT + (size_t)l * D * D : P.WDN + (size_t)l * D * DFF, M, D, o ? D : DFF}; pg8::StaticOrder S; S.init(M, D, F.G, bx);
            pg8::EpiRes E{P.XB, o ? P.BO + l * D : nullptr, o ? P.SSPA : P.SSPB};
            pg8::gemm_phase<pg8::EpiRes, pg8::StaticOrder, false, PG8_SP2>(F.lds + RING_OFF, g, S, E, F.wave); }
        else if (st == 3) {
            pg8::Gemm g{P.XB, P.WUP + (size_t)l * DUP * D, M + 256, DUP, D}; pg8::StaticOrder S; S.init(M + 256, DUP, F.G, bx);
            pg8::EpiUp E{P.H, P.SSPA, P.fdw_w + (size_t)l * 3 * DFF, P.fdw_b + (size_t)l * DFF, (LAS float*)(F.lds + XL_OFF)};
            pg8::gemm_phase<pg8::EpiUp, pg8::StaticOrder, true, PG8_SP2>(F.lds + RING_OFF, g, S, E, F.wave); }
        else { REFRESH(); final_phase(F, P); }
#ifdef DBG_TIMING
        unsigned long long tb0 = 0; if (stamper) tb0 = rt();
#endif
        if (st == -1) { REFRESH(); p0_prologue(F, P); }
        if (ph_ + 1 < hi) xcd_barrier(bar);
#ifdef DBG_TIMING
        if (stamper) { TS[ph_ + 1] = rt(); TS[16] += TS[ph_ + 1] - tb0;
            if (st == DBG_GT_ST) { TS[34] = TS[32]; TS[35] = TS[33]; } else { TS[32] = TS[34]; TS[33] = TS[35]; } }
#endif
    }
#ifdef DBG_TIMING
    if (stamper) { asm volatile("s_waitcnt vmcnt(0) lgkmcnt(0)" ::: "memory");
        float g[8];
        auto dd = [&](int k) { return (float)(TS[k + 1] - TS[k]) * 0.01f; };
        g[0] = dd(0); g[1] = dd(1) + dd(6); g[2] = dd(2) + dd(7); g[3] = dd(3) + dd(8); g[4] = dd(4) + dd(9); g[5] = dd(5) + dd(10); g[6] = dd(11); g[7] = (float)(TS[12] - TS[0]) * 0.01f;
        float g8 = (float)TS[16] * 0.01f, g9 = (float)TS[32] * 0.01f, g10 = (float)TS[33] * 0.01f;
#ifdef DBG_MIX_T
        g9 = (float)TS[36] * 0.01f; g10 = (float)TS[37] * 0.01f;
#endif (void)g8; (void)g9; (void)g10;
        args.out[0] = 0.25f * (DBG_SEL0 < 8 ? g[DBG_SEL0 & 7] : (DBG_SEL0 == 8 ? g8 : (DBG_SEL0 == 9 ? g9 : g10))); args.out[1] = 0.25f * (DBG_SEL1 < 8 ? g[DBG_SEL1 & 7] : (DBG_SEL1 == 8 ? g8 : (DBG_SEL1 == 9 ? g9 : g10))); }
#endif
}

extern "C" void kernel_launch(void* const* d_in, const int* in_sizes, int n_in, void* d_out, int out_size, void* d_ws, size_t ws_size, hipStream_t stream) {
    static int grid = 0;
    if (grid == 0) {
        if (n_in != 18 || in_sizes[0] != M * D || out_size != M * D || ws_size < WS_END) { fprintf(stderr, "kernel_launch: unexpected shapes (n_in %d, ws %zu)\n", n_in, ws_size); grid = -1; return; }
        int dev = 0, cus = 0, per_cu = 0;
        if (hipGetDevice(&dev) != hipSuccess || hipDeviceGetAttribute(&cus, hipDeviceAttributeMultiprocessorCount, dev) != hipSuccess) { grid = -1; return; }
        if (hipFuncSetAttribute((const void*)mega_fwd, hipFuncAttributeMaxDynamicSharedMemorySize, LDS_BYTES) != hipSuccess) { fprintf(stderr, "kernel_launch: hipFuncSetAttribute failed\n"); grid = -1; return; }
        if (hipOccupancyMaxActiveBlocksPerMultiprocessor(&per_cu, (const void*)mega_fwd, NWAVES * 64, LDS_BYTES) != hipSuccess || per_cu < 1) { fprintf(stderr, "kernel_launch: occupancy query says %d blocks per CU\n", per_cu); }
        (void)hipGetLastError();
        grid = cus;
        if (grid != 256) fprintf(stderr, "kernel_launch: %d CUs (the fused epilogues assume 256)\n", grid);
    }
    if (grid < 0) return;
    (void)hipMemsetAsync((char*)d_ws + WS_CTL, 0, CTL_ZERO_BYTES, stream);
    Args a{};
    for (int i = 0; i < 18; ++i) a.in[i] = (const float*)d_in[i];
    a.out = (float*)d_out; a.ws = (unsigned char*)d_ws;
    if (MK_N_LAUNCHES == 1) { a.ph_lo = 0; a.ph_hi = N_PHASES; hipLaunchKernelGGL(mega_fwd, dim3(grid), dim3(NWAVES * 64), LDS_BYTES, stream, a); }
    else for (int p = 0; p < N_PHASES; ++p) { a.ph_lo = p; a.ph_hi = p + 1; hipLaunchKernelGGL(mega_fwd, dim3(grid), dim3(NWAVES * 64), LDS_BYTES, stream, a); }
}
```

```cpp
#include <hip/hip_runtime.h>
#include <cstdio>
#include <cstdint>
constexpr int D = 1024, BATCH = 8, SEQ = 2048, DEPTH = 2, M = BATCH * SEQ;
constexpr int DCONV = 256, DPOOL = 256, DATT = 512, NH = 8, HD = 64, CONVK = 31, DFF = 2816, DIN = 2304, DUP = 2 * DFF;
constexpr float EPS = 1e-6f;
namespace pg8 {
#define PG8_LAS __attribute__((address_space(3)))
typedef unsigned short bf16_t;
typedef short bf16x8 __attribute__((ext_vector_type(8)));
typedef float f32x4 __attribute__((ext_vector_type(4)));
typedef unsigned u32x4 __attribute__((ext_vector_type(4)));
constexpr int BM = 256, BK = 64, HALF = 128, HTB = HALF * BK * 2  , STAGE_BYTES = 8 * HTB, NXCD = 8, WGM = 8;

__host__ __device__ __forceinline__ int lds_byte(int r, int c) { const int st = (r >> 4) * 2 + (c >> 5), rr = r & 15, cc = c & 31, ob = rr * 64 + cc * 2; return st * 1024 + (ob ^ (((ob >> 9) & 1) << 5)); }
__host__ __device__ __forceinline__ void stage_rc(int b, int& R, int& C) { const int st = b / 1024, sb = b % 1024, swz = sb ^ (((sb >> 9) & 1) << 5); R = (st >> 1) * 16 + swz / 64; C = (st & 1) * 32 + (swz % 64) / 2; }
__host__ __device__ __forceinline__ int perm32(int rho) { const int n = rho >> 4, i = rho & 15; return 8 * (i >> 2) + 4 * n + (i & 3); }

struct Unit { int pm, pn; };
struct Gemm { const bf16_t* A; const bf16_t* Bt; int M, N, K; };

struct StaticOrder {
    int nM, nN, nwg, G, c;
    __host__ __device__ void init(int M, int N, int G_, int c_) { nM = M / BM; nN = N / BM; nwg = nM * nN; G = G_; c = c_; }
    __host__ __device__ bool next(int i, Unit& u) const {
        const long L = (long)i * G + c; if (L >= nwg) return false;
        int wgid = (int)L; { const int q = nwg / NXCD, r = nwg % NXCD, xcd = wgid % NXCD, off = wgid / NXCD; wgid = (xcd < r ? xcd * (q + 1) : r * (q + 1) + (xcd - r) * q) + off; }
        const int nig = WGM * nN, gid = wgid / nig, fm = gid * WGM, gsz = (nM - fm) < WGM ? (nM - fm) : WGM;
        u.pm = fm + ((wgid % nig) % gsz); u.pn = (wgid % nig) / gsz; return true;
    }
    __device__ __forceinline__ void a_ready(const Unit&) const {}
    __device__ __forceinline__ void done(const Unit&) const {}
};

__device__ __forceinline__ unsigned cvt_pk_bf16(float lo, float hi) { unsigned r; asm volatile("v_cvt_pk_bf16_f32 %0, %1, %2" : "=v"(r) : "v"(lo), "v"(hi)); return r; }
typedef float f32x2 __attribute__((ext_vector_type(2)));
__device__ __forceinline__ f32x2 gelu_pk(f32x2 v) {
    const f32x2 av = __builtin_elementwise_abs(v), d = av * 0.2316418882f + 1.0f;
    f32x2 t; t.x = __builtin_amdgcn_rcpf(d.x); t.y = __builtin_amdgcn_rcpf(d.y);
    f32x2 q = t * 0.5307027145f + (-0.7265760135f); q = q * t + 0.7107068705f; q = q * t + (-0.142248368f); q = q * t + 0.127414796f; q = q * t;
    const f32x2 s = (v * v) * (-0.72134752044f);
    f32x2 e; e.x = __builtin_amdgcn_exp2f(s.x); e.y = __builtin_amdgcn_exp2f(s.y);
    const f32x2 m = v * (q * e), r = v - m;
    f32x2 o; o.x = v.x < 0.f ? m.x : r.x; o.y = v.y < 0.f ? m.y : r.y; return o;
}
template <int X> __device__ __forceinline__ float swz_xor(float v) { return __builtin_bit_cast(float, __builtin_amdgcn_ds_swizzle(__builtin_bit_cast(int, v), (X << 10) | 0x1f)); }
__device__ __forceinline__ float add_xor32(float v) { float a = v, b = v; asm volatile("s_nop 1\n\tv_permlane32_swap_b32 %0, %1" : "+v"(a), "+v"(b)); return a + b; }
__device__ __forceinline__ float wave_sum_all(float v) { v += swz_xor<1>(v); v += swz_xor<2>(v); v += swz_xor<4>(v); v += swz_xor<8>(v); v += swz_xor<16>(v); return add_xor32(v); }
__device__ __forceinline__ float rs_from_s4(const f32x4 s) { return __builtin_amdgcn_rsqf(((s[0] + s[1]) + (s[2] + s[3])) * (1.0f / 1024.0f) + 1e-6f); }
__device__ __forceinline__ float rs_from_ssp(const float* ssp, int R) { return rs_from_s4(*(const f32x4*)(ssp + (size_t)R * 4)); }
template <int CTRL> __device__ __forceinline__ float dppf(float old, float src) { return __builtin_bit_cast(float, __builtin_amdgcn_update_dpp(__builtin_bit_cast(int, old), __builtin_bit_cast(int, src), CTRL, 0xf, 0xf, false)); }
constexpr int DPP_SHR1 = 0x111, DPP_SHR2 = 0x112, DPP_ROR1 = 0x121, DPP_ROR2 = 0x122;

__device__ __forceinline__ int lane_id_now() { int l; asm volatile("v_mbcnt_lo_u32_b32 %0, -1, 0\n\tv_mbcnt_hi_u32_b32 %0, -1, %0" : "=v"(l)); return l; }
typedef __amdgpu_buffer_rsrc_t rsrc_t;
__device__ __forceinline__ rsrc_t make_rsrc(void* p, unsigned bytes) { return __builtin_amdgcn_make_buffer_rsrc(p, (short)0, (int)bytes, 0x00020000); }
__device__ __forceinline__ void st16_wt(rsrc_t r, unsigned byte_off, u32x4 v) { __builtin_amdgcn_raw_buffer_store_b128(v, r, (int)byte_off, 0, 16); }
struct EpiProj {
    static constexpr bool PERM = true, AFTER_DRAIN = false;
    bf16_t* O; int ldc; const float* ssp;
    __device__ __forceinline__ void operator()(const f32x4 (&acc)[2][2][4][2], const Unit& u, int wr, int wc, int fr, int fq) const {
        { const int l_ = lane_id_now(); fr = l_ & 15; fq = l_ >> 4; }
        const int row0 = u.pm * BM + wr * 64 + fr, col0 = u.pn * BM + wc * 32 + 8 * fq; const rsrc_t ro = make_rsrc(O, 16384u * 2304u * 2u);
        f32x4 s4[2][4];
#pragma unroll
        for (int ai = 0; ai < 2; ++ai)
#pragma unroll
            for (int m = 0; m < 4; ++m) s4[ai][m] = *(const f32x4*)(ssp + (size_t)(row0 + ai * HALF + m * 16) * 4);
#pragma unroll
        for (int ai = 0; ai < 2; ++ai)
#pragma unroll
            for (int m = 0; m < 4; ++m) { const int R = row0 + ai * HALF + m * 16; const float sc = rs_from_s4(s4[ai][m]); const unsigned rowb = ((unsigned)R * (unsigned)ldc + (unsigned)col0) * 2u;
#pragma unroll
                for (int bj = 0; bj < 2; ++bj) { const f32x4 v0 = acc[ai][bj][m][0] * sc, v1 = acc[ai][bj][m][1] * sc;
                    u32x4 w; w.x = cvt_pk_bf16(v0[0], v0[1]); w.y = cvt_pk_bf16(v0[2], v0[3]); w.z = cvt_pk_bf16(v1[0], v1[1]); w.w = cvt_pk_bf16(v1[2], v1[3]);
                    st16_wt(ro, rowb + bj * HALF * 2, w); } }
    }
};
struct EpiUp {
    static constexpr bool PERM = true, AFTER_DRAIN = false;
    bf16_t* H; const float* ssp; const float* dww; const float* dwb; PG8_LAS float* xl;
    __device__ __forceinline__ void operator()(f32x4 (&acc)[2][2][4][2], const Unit& u, int wr, int wc, int fr, int fq) const {
        { const int l_ = lane_id_now(); fr = l_ & 15; fq = l_ >> 4; asm volatile("" : "+s"(wr), "+s"(wc)); }
        const bool halo = (u.pm == 64); const rsrc_t rh = make_rsrc(H, 16384u * 2816u * 2u);
        const int ch0 = u.pn * HALF + wc * 32 + 8 * fq;
        f32x4 s4[2][4];
#pragma unroll
        for (int ai = 0; ai < 2; ++ai)
#pragma unroll
            for (int m = 0; m < 4; ++m) { const int rt = ai * HALF + wr * 64 + m * 16 + fr; int R = halo ? 256 * (rt >> 2) - 2 + (rt & 3) : u.pm * BM + rt; R = R < 0 ? 0 : R; s4[ai][m] = *(const f32x4*)(ssp + (size_t)R * 4); }
#pragma unroll
        for (int ai = 0; ai < 2; ++ai)
#pragma unroll
            for (int m = 0; m < 4; ++m) {
                const float sc = rs_from_s4(s4[ai][m]);
#pragma unroll
                for (int bj = 0; bj < 2; ++bj)
#pragma unroll
                    for (int n = 0; n < 2; ++n) acc[ai][bj][m][n] *= sc; }
        if (fr >= 14) {
#pragma unroll
            for (int ai = 0; ai < 2; ++ai)
#pragma unroll
                for (int n = 0; n < 2; ++n) *(PG8_LAS f32x4*)(xl + ((ai * 2 + wr) * 4 + wc) * 64 + (fr - 14) * 32 + fq * 8 + n * 4) = acc[ai][1][3][n]; }
        asm volatile("s_waitcnt lgkmcnt(0)" ::: "memory"); __builtin_amdgcn_s_barrier(); asm volatile("" ::: "memory");
        f32x4 w0[2], w1[2], w2[2], bb[2];
#pragma unroll
        for (int n = 0; n < 2; ++n) { w0[n] = *(const f32x4*)(dww + ch0 + 4 * n); w1[n] = *(const f32x4*)(dww + DFF + ch0 + 4 * n); w2[n] = *(const f32x4*)(dww + 2 * DFF + ch0 + 4 * n); bb[n] = *(const f32x4*)(dwb + ch0 + 4 * n); }
#pragma unroll
        for (int ai = 0; ai < 2; ++ai)
#pragma unroll
            for (int m = 0; m < 4; ++m) {
                f32x4 prev[2];
                if (m > 0) { prev[0] = acc[ai][1][m - 1][0]; prev[1] = acc[ai][1][m - 1][1]; }
                else { prev[0] = (f32x4){0.f, 0.f, 0.f, 0.f}; prev[1] = prev[0];
                    const int sai = wr ? ai : ai - 1, swr = wr ? 0 : 1;
                    if (!halo && sai >= 0 && fr >= 14) {
#pragma unroll
                        for (int n = 0; n < 2; ++n) prev[n] = *(const PG8_LAS f32x4*)(xl + ((sai * 2 + swr) * 4 + wc) * 64 + (fr - 14) * 32 + fq * 8 + n * 4); } }
                f32x4 hv[2];
#pragma unroll
                for (int n = 0; n < 2; ++n) { const f32x4 cur = acc[ai][1][m][n]; f32x4 g1, g2;
#pragma unroll
                    for (int i = 0; i < 4; ++i) { const float p1 = halo ? 0.f : dppf<DPP_ROR1>(0.f, prev[n][i]), p2 = halo ? 0.f : dppf<DPP_ROR2>(0.f, prev[n][i]);
                        g1[i] = dppf<DPP_SHR1>(p1, cur[i]); g2[i] = dppf<DPP_SHR2>(p2, cur[i]); }
                    const f32x4 gc = w0[n] * g2 + w1[n] * g1 + w2[n] * cur + bb[n];
                    const f32x2 ga = gelu_pk((f32x2){gc[0], gc[1]}), gb = gelu_pk((f32x2){gc[2], gc[3]});
                    hv[n] = acc[ai][0][m][n] * (f32x4){ga.x, ga.y, gb.x, gb.y}; }
                const int rt = ai * HALF + wr * 64 + m * 16 + fr;
                u32x4 w; w.x = cvt_pk_bf16(hv[0][0], hv[0][1]); w.y = cvt_pk_bf16(hv[0][2], hv[0][3]); w.z = cvt_pk_bf16(hv[1][0], hv[1][1]); w.w = cvt_pk_bf16(hv[1][2], hv[1][3]);
                if (!halo) { if (!(rt < 2 && (u.pm & 7) != 0)) st16_wt(rh, ((unsigned)(u.pm * BM + rt) * (unsigned)DFF + (unsigned)ch0) * 2u, w); }
                else { const int k = rt >> 2, j = rt & 3; if (j >= 2 && (k & 7) != 0) st16_wt(rh, ((unsigned)(256 * k + j - 2) * (unsigned)DFF + (unsigned)ch0) * 2u, w); }
            }
    }
};
struct EpiRes {
    static constexpr bool PERM = true, AFTER_DRAIN = true;
    bf16_t* XB; const float* bias; float* sspo;
    __device__ __forceinline__ void fused(f32x4 (&acc)[2][2][4][2], const Unit& u, int wr, int wc, int fr, int fq, PG8_LAS unsigned char* lds, int wid, int lane) const {
        PG8_LAS float* P = (PG8_LAS float*)lds;
        { const int l_ = lane_id_now(); fr = l_ & 15; fq = l_ >> 4; lane = l_; }
        const int col0 = u.pn * BM + wc * 32 + 8 * fq; const rsrc_t rx = make_rsrc(XB, (16384u + 256u) * 1024u * 2u);
        f32x4 bv[2][2];
#pragma unroll
        for (int bj = 0; bj < 2; ++bj)
#pragma unroll
            for (int n = 0; n < 2; ++n) bv[bj][n] = bias ? *(const f32x4*)(bias + col0 + bj * HALF + 4 * n) : (f32x4){0.f, 0.f, 0.f, 0.f};
        u32x4 xin[2][4][2];
#pragma unroll
        for (int ai = 0; ai < 2; ++ai)
#pragma unroll
            for (int m = 0; m < 4; ++m)
#pragma unroll
                for (int bj = 0; bj < 2; ++bj) xin[ai][m][bj] = __builtin_amdgcn_raw_buffer_load_b128(rx, (int)(((unsigned)(u.pm * BM + ai * HALF + wr * 64 + m * 16 + fr) * 1024u + (unsigned)col0) * 2u + bj * HALF * 2), 0, 0);
#pragma unroll
        for (int ai = 0; ai < 2; ++ai)
#pragma unroll
            for (int m = 0; m < 4; ++m) { const int rt = ai * HALF + wr * 64 + m * 16 + fr, R = u.pm * BM + rt; const unsigned off = ((unsigned)R * 1024u + (unsigned)col0) * 2u; float s = 0.f;
                int hr = -1; if (rt < 2) hr = 16384 + 4 * u.pm + 2 + rt; else if (rt >= 254) hr = 16384 + 4 * (u.pm + 1) + (rt - 254);
#pragma unroll
                for (int bj = 0; bj < 2; ++bj) { const u32x4 xb = xin[ai][m][bj];
                    f32x4 x0, x1;
                    x0[0] = __builtin_bit_cast(float, xb[0] << 16); x0[1] = __builtin_bit_cast(float, xb[0] & 0xffff0000u); x0[2] = __builtin_bit_cast(float, xb[1] << 16); x0[3] = __builtin_bit_cast(float, xb[1] & 0xffff0000u);
                    x1[0] = __builtin_bit_cast(float, xb[2] << 16); x1[1] = __builtin_bit_cast(float, xb[2] & 0xffff0000u); x1[2] = __builtin_bit_cast(float, xb[3] << 16); x1[3] = __builtin_bit_cast(float, xb[3] & 0xffff0000u);
                    x0 = x0 + acc[ai][bj][m][0] + bv[bj][0]; x1 = x1 + acc[ai][bj][m][1] + bv[bj][1];
                    s += ((x0[0] * x0[0] + x0[1] * x0[1]) + (x0[2] * x0[2] + x0[3] * x0[3])) + ((x1[0] * x1[0] + x1[1] * x1[1]) + (x1[2] * x1[2] + x1[3] * x1[3]));
                    u32x4 w; w.x = cvt_pk_bf16(x0[0], x0[1]); w.y = cvt_pk_bf16(x0[2], x0[3]); w.z = cvt_pk_bf16(x1[0], x1[1]); w.w = cvt_pk_bf16(x1[2], x1[3]);
                    st16_wt(rx, off + bj * HALF * 2, w);
                    if (hr >= 0 && hr < 16384 + 256) st16_wt(rx, ((unsigned)hr * 1024u + (unsigned)col0) * 2u + bj * HALF * 2, w); }
                s += swz_xor<16>(s); s = add_xor32(s);
                if (fq == 0) P[rt * 4 + wc] = s; }
        asm volatile("s_waitcnt lgkmcnt(0)" ::: "memory"); __builtin_amdgcn_s_barrier(); asm volatile("" ::: "memory");
        const int tid = wid * 64 + lane;
        if (tid < 256) { const f32x4 p = *(const PG8_LAS f32x4*)(P + tid * 4); sspo[(size_t)(u.pm * BM + tid) * 4 + u.pn] = (p[0] + p[1]) + (p[2] + p[3]); }
        asm volatile("s_waitcnt lgkmcnt(0)" ::: "memory"); __builtin_amdgcn_s_barrier(); asm volatile("" ::: "memory");
    }
};
template <class Epi, class Sched, bool ALIGN_EPI = false, bool SP2 = false>
__device__ __forceinline__ void gemm_phase(PG8_LAS unsigned char* lds, const Gemm g, const Sched& S, const Epi& E, int wave_id  ) {
    int tid_; asm volatile("v_mbcnt_lo_u32_b32 %0, -1, 0\n\tv_mbcnt_hi_u32_b32 %0, -1, %0" : "=v"(tid_)); tid_ += 64 * wave_id;
    const int tid = tid_, wid = __builtin_amdgcn_readfirstlane(tid >> 6), lane = tid & 63, wr = wid >> 2, wc = wid & 3, fr = lane & 15, fq = lane >> 4;
    const int K = g.K, nt = K / BK;
    unsigned voffA[2], voffB[2];
#pragma unroll
    for (int i = 0; i < 2; ++i) { int R, C; stage_rc(tid * 16 + i * 8192, R, C); const int Rb = Epi::PERM ? ((R & ~31) + perm32(R & 31)) : R;
        voffA[i] = (unsigned)(R * K + C) * 2u; voffB[i] = (unsigned)(Rb * K + C) * 2u; }
    const size_t kstep = (size_t)(BK * 2);
    const size_t hstep = (size_t)HALF * K * 2;
    const size_t tstep = 2 * hstep;
    const unsigned ldsw = (unsigned)wid * 1024u;
    const int aoff = lds_byte(wr * 64 + fr, fq * 8), boff = lds_byte(wc * 32 + fr, fq * 8);
#define PG8_SA(b, h) (((b) * 2 + (h)) * HTB)
#define PG8_SB(b, h) ((4 + (b) * 2 + (h)) * HTB)
#define PG8_STAGE(bufoff, gbase, voff) do { _Pragma("unroll") for (int _i = 0; _i < 2; ++_i) \
        __builtin_amdgcn_global_load_lds((const unsigned*)((const char*)(gbase) + (voff)[_i]), (PG8_LAS unsigned*)(lds + (bufoff) + ldsw + _i * 8192), 16, 0, 0); } while (0)
#define PG8_LDA(dst, b, h) do { _Pragma("unroll") for (int m = 0; m < 4; ++m) _Pragma("unroll") for (int k = 0; k < 2; ++k) dst[m][k] = *(const PG8_LAS bf16x8*)(lds + PG8_SA(b, h) + aoff + m * 2048 + k * 1024); } while (0)
#define PG8_LDB(dst, b, h) do { _Pragma("unroll") for (int n = 0; n < 2; ++n) _Pragma("unroll") for (int k = 0; k < 2; ++k) dst[n][k] = *(const PG8_LAS bf16x8*)(lds + PG8_SB(b, h) + boff + n * 2048 + k * 1024); } while (0)
#define PG8_MMA(ai, bj, At, Bt) do { __builtin_amdgcn_s_setprio(1); _Pragma("unroll") for (int m = 0; m < 4; ++m) _Pragma("unroll") for (int n = 0; n < 2; ++n) _Pragma("unroll") for (int k = 0; k < 2; ++k) \
        acc[ai][bj][m][n] = __builtin_amdgcn_mfma_f32_16x16x32_bf16(Bt[n][k], At[m][k], acc[ai][bj][m][n], 0, 0, 0); __builtin_amdgcn_s_setprio(0); } while (0)
#define PG8_WAIT_V(n) asm volatile("s_waitcnt vmcnt(" #n ")" ::: "memory")
#define PG8_WAIT_L(n) asm volatile("s_waitcnt lgkmcnt(" #n ")" ::: "memory")
#define PG8_BAR __builtin_amdgcn_s_barrier()
#define PG8_SCHED __builtin_amdgcn_sched_barrier(0)
    Unit cur, nxt; int ui = 0;
    if (!S.next(0, cur)) return;
    f32x4 acc[2][2][4][2];
#pragma unroll
    for (int a = 0; a < 2; ++a)
#pragma unroll
        for (int b = 0; b < 2; ++b)
#pragma unroll
            for (int m = 0; m < 4; ++m)
#pragma unroll
                for (int n = 0; n < 2; ++n) acc[a][b][m][n] = (f32x4){0.f, 0.f, 0.f, 0.f};
    bf16x8 At[4][2], B0[2][2], B1[2][2];
    const char* cA = (const char*)g.A + (size_t)cur.pm * tstep; const char* cB = (const char*)g.Bt + (size_t)cur.pn * tstep;
    S.a_ready(cur);
    if constexpr (SP2) {
        PG8_STAGE(PG8_SB(0, 0), cB, voffB); PG8_STAGE(PG8_SB(0, 1), cB + hstep, voffB); PG8_STAGE(PG8_SA(0, 0), cA, voffA); PG8_STAGE(PG8_SA(0, 1), cA + hstep, voffA);
        if (wr == 1) PG8_BAR;
        PG8_WAIT_V(2); PG8_BAR;
        PG8_STAGE(PG8_SB(1, 0), cB + kstep, voffB); PG8_STAGE(PG8_SA(1, 0), cA + kstep, voffA); PG8_STAGE(PG8_SB(1, 1), cB + hstep + kstep, voffB);
        PG8_WAIT_V(6); PG8_BAR;
    } else {
        PG8_STAGE(PG8_SB(0, 0), cB, voffB); PG8_STAGE(PG8_SA(0, 0), cA, voffA); PG8_STAGE(PG8_SB(0, 1), cB + hstep, voffB); PG8_STAGE(PG8_SA(0, 1), cA + hstep, voffA);
        if (wr == 1) PG8_BAR;
        PG8_WAIT_V(4); PG8_BAR;
        PG8_STAGE(PG8_SB(1, 0), cB + kstep, voffB); PG8_STAGE(PG8_SA(1, 0), cA + kstep, voffA); PG8_STAGE(PG8_SB(1, 1), cB + hstep + kstep, voffB);
        PG8_WAIT_V(6); PG8_BAR;
    }
#ifdef DBG_GEMM_T
    volatile PG8_LAS unsigned long long* GT = (volatile PG8_LAS unsigned long long*)(lds + 135488 + 512); const bool gt_on = (blockIdx.x == 0 && tid == 0); unsigned long long gt0 = 0;
#endif
    for (;;) {
#ifdef DBG_GEMM_T
        if (gt_on) gt0 = __builtin_amdgcn_s_memrealtime();
#endif
        const bool has_next = S.next(ui + 1, nxt);
        const char* nA = has_next ? (const char*)g.A + (size_t)nxt.pm * tstep : cA; const char* nB = has_next ? (const char*)g.Bt + (size_t)nxt.pn * tstep : cB;
        for (int t = 0; t < nt; t += 2) {
            const bool last = (t == nt - 2);
            const char* a1 = cA + (size_t)(t + 1) * kstep;
            const char* a2 = last ? nA : cA + (size_t)(t + 2) * kstep; const char* b2 = last ? nB : cB + (size_t)(t + 2) * kstep;
            const char* a3 = a2 + kstep; const char* b3 = b2 + kstep;
            if (last && has_next) S.a_ready(nxt);
            if constexpr (SP2) {
            PG8_LDB(B0, 0, 0); PG8_LDB(B1, 0, 1); PG8_SCHED; PG8_LDA(At, 0, 0); PG8_STAGE(PG8_SA(1, 1), a1 + hstep, voffA);
            PG8_WAIT_V(8); PG8_WAIT_L(0); PG8_BAR; PG8_MMA(0, 0, At, B0); PG8_MMA(0, 1, At, B1); PG8_BAR; PG8_SCHED;
            PG8_LDA(At, 0, 1); PG8_STAGE(PG8_SB(0, 0), b2, voffB); PG8_STAGE(PG8_SB(0, 1), b2 + hstep, voffB); PG8_STAGE(PG8_SA(0, 0), a2, voffA);
            PG8_WAIT_V(8); PG8_WAIT_L(0); PG8_BAR; PG8_MMA(1, 0, At, B0); PG8_MMA(1, 1, At, B1); PG8_BAR; PG8_SCHED;
            PG8_LDB(B0, 1, 0); PG8_LDB(B1, 1, 1); PG8_SCHED; PG8_LDA(At, 1, 0); PG8_STAGE(PG8_SA(0, 1), a2 + hstep, voffA);
            PG8_WAIT_V(8); PG8_WAIT_L(0); PG8_BAR; PG8_MMA(0, 0, At, B0); PG8_MMA(0, 1, At, B1); PG8_BAR; PG8_SCHED;
            PG8_LDA(At, 1, 1); PG8_STAGE(PG8_SB(1, 0), b3, voffB); PG8_STAGE(PG8_SB(1, 1), b3 + hstep, voffB); PG8_STAGE(PG8_SA(1, 0), a3, voffA);
            PG8_WAIT_V(8); PG8_WAIT_L(0); PG8_BAR; PG8_MMA(1, 0, At, B0); PG8_MMA(1, 1, At, B1); PG8_BAR; PG8_SCHED;
            } else {
            PG8_LDB(B0, 0, 0); PG8_SCHED; PG8_LDA(At, 0, 0); PG8_STAGE(PG8_SA(1, 1), a1 + hstep, voffA);
            PG8_WAIT_L(8); PG8_BAR; PG8_WAIT_L(0); PG8_MMA(0, 0, At, B0); PG8_BAR; PG8_SCHED;
            PG8_LDB(B1, 0, 1); PG8_STAGE(PG8_SB(0, 0), b2, voffB);
            PG8_BAR; PG8_WAIT_L(0); PG8_MMA(0, 1, At, B1); PG8_BAR;
            PG8_LDA(At, 0, 1); PG8_STAGE(PG8_SA(0, 0), a2, voffA);
            PG8_BAR; PG8_WAIT_L(0); PG8_MMA(1, 0, At, B0); PG8_BAR; PG8_SCHED;
            PG8_STAGE(PG8_SB(0, 1), b2 + hstep, voffB);
            PG8_WAIT_V(6); PG8_BAR; PG8_MMA(1, 1, At, B1); PG8_BAR;
            PG8_LDB(B0, 1, 0); PG8_SCHED; PG8_LDA(At, 1, 0); PG8_STAGE(PG8_SA(0, 1), a2 + hstep, voffA);
            PG8_WAIT_L(8); PG8_BAR; PG8_WAIT_L(0); PG8_MMA(0, 0, At, B0); PG8_BAR; PG8_SCHED;
            PG8_LDB(B1, 1, 1); PG8_STAGE(PG8_SB(1, 0), b3, voffB);
            PG8_BAR; PG8_WAIT_L(0); PG8_MMA(0, 1, At, B1); PG8_BAR;
            PG8_LDA(At, 1, 1); PG8_STAGE(PG8_SA(1, 0), a3, voffA);
            PG8_BAR; PG8_WAIT_L(0); PG8_MMA(1, 0, At, B0); PG8_BAR; PG8_SCHED;
            PG8_STAGE(PG8_SB(1, 1), b3 + hstep, voffB);
            PG8_WAIT_V(6); PG8_BAR; PG8_MMA(1, 1, At, B1); PG8_BAR;
            }
        }
        if constexpr (ALIGN_EPI) { if (wr == 0) PG8_BAR; }
#ifdef DBG_GEMM_T
        if (gt_on) { const unsigned long long t1 = __builtin_amdgcn_s_memrealtime(); GT[0] += t1 - gt0; gt0 = t1; }
#endif
        if constexpr (!Epi::AFTER_DRAIN) { E(acc, cur, wr, wc, fr, fq); S.done(cur); }
#ifdef DBG_GEMM_T
        if (gt_on) { const unsigned long long t1 = __builtin_amdgcn_s_memrealtime(); GT[1] += t1 - gt0; }
#endif
        if (!has_next) break;
#pragma unroll
        for (int a = 0; a < 2; ++a)
#pragma unroll
            for (int b = 0; b < 2; ++b)
#pragma unroll
                for (int m = 0; m < 4; ++m)
#pragma unroll
                    for (int n = 0; n < 2; ++n) acc[a][b][m][n] = (f32x4){0.f, 0.f, 0.f, 0.f};
        cur = nxt; cA = nA; cB = nB; ++ui;
        if constexpr (ALIGN_EPI) { if (wr == 1) PG8_BAR; }
    }
    PG8_WAIT_V(0);
    if constexpr (!ALIGN_EPI) { if (wr == 0) PG8_BAR; }
    PG8_BAR;
    if constexpr (Epi::AFTER_DRAIN) { E.fused(acc, cur, wr, wc, fr, fq, lds, wid, lane); S.done(cur); }
#undef PG8_SA
#undef PG8_SB
#undef PG8_STAGE
#undef PG8_LDA
#undef PG8_LDB
#undef PG8_MMA
#undef PG8_WAIT_V
#undef PG8_WAIT_L
#undef PG8_BAR
#undef PG8_SCHED
}
}

#ifndef PG8_SP2
#define PG8_SP2 true
#endif
#ifndef PG8_ALIGN
#define PG8_ALIGN true
#endif
#define GAS __attribute__((address_space(1)))
#define LAS __attribute__((address_space(3)))
typedef unsigned short bf16;
typedef unsigned v4u __attribute__((ext_vector_type(4)));
typedef float f32x4 __attribute__((ext_vector_type(4)));
typedef short bf16x8 __attribute__((ext_vector_type(8)));
typedef GAS unsigned gu32;
typedef GAS unsigned long long gu64;
#define RLX_AGENT __ATOMIC_RELAXED, __HIP_MEMORY_SCOPE_AGENT
#define LDS_WAIT() asm volatile("s_waitcnt lgkmcnt(0)" ::: "memory")
#define VM_WAIT() asm volatile("s_waitcnt vmcnt(0)" ::: "memory")
__device__ __forceinline__ unsigned long long rt() { return __builtin_amdgcn_s_memrealtime(); }
__device__ __forceinline__ unsigned f2bf(float f) { unsigned u = __builtin_bit_cast(unsigned, f); return (u + 0x7fffu + ((u >> 16) & 1u)) >> 16; }
__device__ __forceinline__ unsigned pk2(float lo, float hi) { return f2bf(lo) | (f2bf(hi) << 16); }

#define XB_TMO      128
#define XB_XCNT(j)  (256  + 64 * (j))
#define XB_XSUB(j)  (1280 + 64 * (j))
#define XB_XGEN(j)  (2304 + 64 * (j))
#define XB_TOP      3328
#define XB_TOPGEN   3392
#define XCD_BAR_WORDS 3456
#define XB_SPIN_CAP (1u << 18)

__device__ __forceinline__ unsigned xb_ld(unsigned* p)              { return __hip_atomic_load(p, __ATOMIC_RELAXED, __HIP_MEMORY_SCOPE_AGENT); }
__device__ __forceinline__ unsigned xb_add(unsigned* p, unsigned v) { return __hip_atomic_fetch_add(p, v, __ATOMIC_RELAXED, __HIP_MEMORY_SCOPE_AGENT); }
__device__ __forceinline__ unsigned xb_xcc_id() { return (unsigned)__builtin_amdgcn_s_getreg((3 << 11) | 20) & 0xFu; }
#define XB_SPIN(cond, bar) do { unsigned _sp = 0; while (cond) { __builtin_amdgcn_s_sleep(1); \
    if ((++_sp & 255u) == 0u) { if (xb_ld(&(bar)[XB_TMO])) break; if (_sp > XB_SPIN_CAP) { atomicAdd(&(bar)[XB_TMO], 1u); break; } } } } while (0)

struct XcdBarrier {
    unsigned* bar; unsigned x;
    volatile LAS unsigned* st;
};

__device__ __forceinline__ XcdBarrier xcd_barrier_post(unsigned* bar, volatile LAS unsigned* st) {
    XcdBarrier b; b.bar = bar; b.x = xb_xcc_id(); b.st = st;
    if (threadIdx.x == 0) (void)xb_add(&bar[XB_XCNT(b.x)], 1u);
    return b;
}
__device__ __forceinline__ void xcd_barrier_complete(unsigned* bar, unsigned x, unsigned& nloc, unsigned& nx) {
    const unsigned G = gridDim.x * gridDim.y * gridDim.z;
    unsigned sum, cnt, mine, sp = 0u;
    for (;;) {
        sum = 0u; cnt = 0u; mine = 0u;
#pragma unroll
        for (unsigned j = 0; j < 16; ++j) { const unsigned c = xb_ld(&bar[XB_XCNT(j)]); sum += c; cnt += (c > 0u) ? 1u : 0u; }
        mine = xb_ld(&bar[XB_XCNT(x)]);
        if (sum == G) break;
        __builtin_amdgcn_s_sleep(1);
        if ((++sp & 255u) == 0u) { if (xb_ld(&bar[XB_TMO])) break; if (sp > XB_SPIN_CAP) { atomicAdd(&bar[XB_TMO], 1u); break; } }
    }
    nloc = mine > 0u ? mine : 1u; nx = cnt > 0u ? cnt : 1u;
}

__device__ __forceinline__ void xcd_barrier(const XcdBarrier& b) {
    asm volatile("s_waitcnt vmcnt(0)" ::: "memory");
    __syncthreads();
    if (threadIdx.x == 0) {
        unsigned* bar = b.bar;
        __builtin_amdgcn_s_waitcnt(0);
        unsigned nloc = b.st[0], nx = b.st[1];
        if (nloc == 0u) { xcd_barrier_complete(bar, b.x, nloc, nx); b.st[0] = nloc; b.st[1] = nx; }
        const unsigned old = xb_add(&bar[XB_XSUB(b.x)], 1u);
        const unsigned gen = old / nloc;
        if (old + 1u == (gen + 1u) * nloc) {
            __builtin_amdgcn_fence(__ATOMIC_RELEASE, "agent");
            asm volatile("s_waitcnt vmcnt(0)" ::: "memory");
            const unsigned og = xb_add(&bar[XB_TOP], 1u);
            const unsigned tg = og / nx;
            if (og + 1u == (tg + 1u) * nx) xb_add(&bar[XB_TOPGEN], 1u);
            else XB_SPIN(xb_ld(&bar[XB_TOPGEN]) == tg, bar);
            __builtin_amdgcn_fence(__ATOMIC_ACQUIRE, "agent");
            xb_add(&bar[XB_XGEN(b.x)], 1u);
            asm volatile("s_waitcnt vmcnt(0)" ::: "memory");
        } else {
            XB_SPIN(xb_ld(&bar[XB_XGEN(b.x)]) == gen, bar);
            __builtin_amdgcn_fence(__ATOMIC_ACQUIRE, "agent");
            asm volatile("s_waitcnt vmcnt(0)" ::: "memory");
        }
    }
    __syncthreads();
}

namespace sba {
typedef short bf16x8 __attribute__((ext_vector_type(8)));
typedef short s16x4 __attribute__((ext_vector_type(4)));
typedef float f32x16 __attribute__((ext_vector_type(16)));
typedef unsigned u32x4 __attribute__((ext_vector_type(4)));
constexpr int PITCH = DIN, QOFF = 768, KOFF = 1280, VOFF = 1792, MIXOFF = 512;
constexpr int SLOTB = 8192, LDS_K = 0, LDS_V = 2 * SLOTB, LDS_OST = 4 * SLOTB, LDS_FLG = LDS_OST + 8 * 4096, LDS_BYTES_ATT = LDS_FLG + 64;
constexpr float CARRY_ZERO = 152.0f;
__device__ __forceinline__ int crow(int r, int hi) { return (r & 3) + 8 * (r >> 2) + 4 * hi; }
__device__ __forceinline__ void glds16(const void* gsrc, unsigned lds_dst) { unsigned keep;
    asm volatile("s_mov_b32 %0, m0\n\ts_mov_b32 m0, %2\n\ts_nop 0\n\tglobal_load_lds_dwordx4 %1, off\n\ts_mov_b32 m0, %0" : "=&s"(keep) : "v"(gsrc), "s"(lds_dst) : "memory"); }
typedef float f32x2_t __attribute__((ext_vector_type(2))); typedef __bf16 bf16x2_t __attribute__((ext_vector_type(2)));
__device__ __forceinline__ unsigned cvtpk_s(float lo, float hi) { f32x2_t v = {lo, hi}; bf16x2_t b = __builtin_convertvector(v, bf16x2_t); return __builtin_bit_cast(unsigned, b); }
#define SBA_WAIT_BAR() asm volatile("s_waitcnt vmcnt(0) lgkmcnt(0)\n\ts_barrier" ::: "memory")
#define SBA_SBAR() __builtin_amdgcn_sched_barrier(0)
typedef __attribute__((address_space(3))) const char* lds_cptr;
__device__ __forceinline__ void kload8(bf16x8* kf, lds_cptr kp) {
    kf[0] = *(const __attribute__((address_space(3))) bf16x8*)(kp);        kf[1] = *(const __attribute__((address_space(3))) bf16x8*)(kp + 512);
    kf[2] = *(const __attribute__((address_space(3))) bf16x8*)(kp + 2048); kf[3] = *(const __attribute__((address_space(3))) bf16x8*)(kp + 2560);
    kf[4] = *(const __attribute__((address_space(3))) bf16x8*)(kp + 4096); kf[5] = *(const __attribute__((address_space(3))) bf16x8*)(kp + 4608);
    kf[6] = *(const __attribute__((address_space(3))) bf16x8*)(kp + 6144); kf[7] = *(const __attribute__((address_space(3))) bf16x8*)(kp + 6656);
}
#define SBA_MFMA(a, b, c) __builtin_amdgcn_mfma_f32_32x32x16_bf16((a), (b), (c), 0, 0, 0)
__device__ __forceinline__ void pv(f32x16* o, int vb, bf16x8 pa0, bf16x8 pa1, bf16x8 pa2, bf16x8 pa3) {
#pragma unroll
    for (int d0 = 0; d0 < 2; ++d0) { s16x4 lo[4], hi[4];
#pragma unroll
        for (int ks = 0; ks < 4; ++ks) {
            asm volatile("ds_read_b64_tr_b16 %0,%1 offset:%c2" : "=&v"(lo[ks]) : "v"(vb), "i"(d0 * 4096 + ks * 1024) : "memory");
            asm volatile("ds_read_b64_tr_b16 %0,%1 offset:%c2" : "=&v"(hi[ks]) : "v"(vb), "i"(d0 * 4096 + ks * 1024 + 512) : "memory"); }
        asm volatile("s_waitcnt lgkmcnt(0)" ::: "memory"); SBA_SBAR();
#define SBA_PK(k) (bf16x8){lo[k][0], lo[k][1], lo[k][2], lo[k][3], hi[k][0], hi[k][1], hi[k][2], hi[k][3]}
        o[d0] = SBA_MFMA(pa0, SBA_PK(0), o[d0]); o[d0] = SBA_MFMA(pa1, SBA_PK(1), o[d0]); o[d0] = SBA_MFMA(pa2, SBA_PK(2), o[d0]); o[d0] = SBA_MFMA(pa3, SBA_PK(3), o[d0]);
#undef SBA_PK
    }
}
__device__ __forceinline__ bf16x8 pack8(const f32x16& x, int b) { u32x4 p; p[0] = cvtpk_s(x[b], x[b + 1]); p[1] = cvtpk_s(x[b + 2], x[b + 3]); p[2] = cvtpk_s(x[b + 4], x[b + 5]); p[3] = cvtpk_s(x[b + 6], x[b + 7]); return __builtin_bit_cast(bf16x8, p); }

__device__ __forceinline__ void attn_unit(int b, int h, int qb, const unsigned short* PROJ, unsigned short* MIX, char* shm, int wid, int lane) {
    const int r32 = lane & 31, hi = lane >> 5;
    const long rowbase = (long)b * SEQ; const int q0 = qb * 256;
    const unsigned short* Qw = PROJ + (rowbase + q0 + wid * 32) * PITCH + QOFF + h * 64;
    const unsigned short* Kh = PROJ + rowbase * PITCH + KOFF + h * 64; const unsigned short* Vh = PROJ + rowbase * PITCH + VOFF + h * 64;
    const unsigned lds0 = (unsigned)(uintptr_t)shm;
    const unsigned short* ksrc = Kh + (long)lane * PITCH + wid * 8;
    const unsigned short* vsrc = Vh + (long)(16 * (wid & 3) + (lane >> 2)) * PITCH + (wid >> 2) * 32 + (lane & 3) * 8;
    const unsigned kdst = lds0 + LDS_K + wid * 1024, vdst = lds0 + LDS_V + wid * 1024;
#define SBA_DMA(t, slot) do { glds16(ksrc + (long)(t) * 64 * PITCH, (unsigned)__builtin_amdgcn_readfirstlane(kdst + (slot))); glds16(vsrc + (long)(t) * 64 * PITCH, (unsigned)__builtin_amdgcn_readfirstlane(vdst + (slot))); } while (0)
    const int vb0 = (int)(lds0 + LDS_V) + ((lane >> 4) & 1) * 32 + (lane & 3) * 8 + (4 * hi + ((lane & 15) >> 2)) * 64;
    const lds_cptr kp0 = (lds_cptr)shm + LDS_K + hi * 1024 + r32 * 16;
    const int NT = 4 * (qb + 1);
    SBA_DMA(NT - 1, 0);
    bf16x8 qr[4];
#pragma unroll
    for (int d0 = 0; d0 < 4; ++d0) qr[d0] = *reinterpret_cast<const bf16x8*>(&Qw[(long)r32 * PITCH + d0 * 16 + hi * 8]);
    bf16x8 U0, U1, J;
#pragma unroll
    for (int j = 0; j < 8; ++j) { const int k0 = 8 * (j >> 2) + 4 * hi + (j & 3); U0[j] = (k0 >= r32) ? (short)0x3F80 : (short)0; U1[j] = (16 + k0 >= r32) ? (short)0x3F80 : (short)0; J[j] = (short)0x3F80; }
    f32x16 C, o[2];
#pragma unroll
    for (int r = 0; r < 16; ++r) { C[r] = 0.f; o[0][r] = 0.f; o[1][r] = 0.f; }
    const int qrel = wid * 32 + r32;
    volatile __attribute__((address_space(3))) int* flg = (volatile __attribute__((address_space(3))) int*)((lds_cptr)shm + LDS_FLG);
    if (lane == 0) flg[wid] = 0x7fffffff;
    bool wdone = false;
    SBA_WAIT_BAR();
    for (int i = 0; i < NT; ++i) {
        const int t = NT - 1 - i, slot = (i & 1) * SLOTB, jb = t - 4 * qb;
        if (i + 1 < NT) SBA_DMA(t - 1, slot ^ SLOTB);
        if (!wdone && !(jb >= 0 && 2 * jb > wid)) {
            bf16x8 kf[8]; kload8(kf, kp0 + slot);
            f32x16 z0, z1;
#pragma unroll
            for (int r = 0; r < 16; ++r) { z0[r] = 0.f; z1[r] = 0.f; }
#pragma unroll
            for (int s = 0; s < 4; ++s) { z0 = SBA_MFMA(kf[2 * s], qr[s], z0); z1 = SBA_MFMA(kf[2 * s + 1], qr[s], z1); }
            if (jb >= 0) { const int kb = 64 * jb + 4 * hi;
#pragma unroll
                for (int r = 0; r < 16; ++r) { const int kv = kb + (r & 3) + 8 * (r >> 2); if (kv >= qrel) z0[r] = -INFINITY; if (kv + 32 >= qrel) z1[r] = -INFINITY; } }
            f32x16 s0, s1;
#pragma unroll
            for (int r = 0; r < 16; ++r) { s0[r] = fmaxf(z0[r], 0.f) + __builtin_amdgcn_logf(1.0f + __builtin_amdgcn_exp2f(-fabsf(z0[r]))); s1[r] = fmaxf(z1[r], 0.f) + __builtin_amdgcn_logf(1.0f + __builtin_amdgcn_exp2f(-fabsf(z1[r]))); }
            const bf16x8 f00 = pack8(s0, 0), f01 = pack8(s0, 8), f10 = pack8(s1, 0), f11 = pack8(s1, 8);
            f32x16 Dv = SBA_MFMA(J, f10, C); Dv = SBA_MFMA(J, f11, Dv);
            f32x16 c1 = SBA_MFMA(U0, f10, C); c1 = SBA_MFMA(U1, f11, c1);
            f32x16 c0 = SBA_MFMA(U0, f00, Dv); c0 = SBA_MFMA(U1, f01, c0);
            C = SBA_MFMA(J, f00, Dv); C = SBA_MFMA(J, f01, C);
#pragma unroll
            for (int r = 0; r < 16; ++r) { z0[r] = __builtin_amdgcn_exp2f(z0[r] - c0[r]); z1[r] = __builtin_amdgcn_exp2f(z1[r] - c1[r]); }
            const bf16x8 p0 = pack8(z0, 0), p1 = pack8(z0, 8), p2 = pack8(z1, 0), p3 = pack8(z1, 8);
            pv(o, vb0 + slot, p0, p1, p2, p3);
            if (__all(C[0] >= CARRY_ZERO)) { wdone = true; if (lane == 0) flg[wid] = i; }
        }
        SBA_WAIT_BAR();
        { int m = flg[0];
#pragma unroll
          for (int w = 1; w < 8; ++w) { const int f = flg[w]; m = f > m ? f : m; }
          if (__builtin_amdgcn_readfirstlane(m) <= i) break; }
    }
    { unsigned short* stg = (unsigned short*)(shm + LDS_OST) + wid * 2048;
#pragma unroll
      for (int r = 0; r < 16; ++r) { const int orow = crow(r, hi);
#pragma unroll
          for (int d0 = 0; d0 < 2; ++d0) stg[orow * 64 + d0 * 32 + r32] = (unsigned short)(cvtpk_s(o[d0][r], 0.f) & 0xffffu); }
      asm volatile("s_waitcnt lgkmcnt(0)" ::: "memory");
      const __amdgpu_buffer_rsrc_t rmix = __builtin_amdgcn_make_buffer_rsrc((void*)MIX, (short)0, (int)(16384u * 1024u * 2u), 0x00020000);
#pragma unroll
      for (int i = 0; i < 4; ++i) { const int row = i * 8 + (lane >> 3), ch = lane & 7; const u32x4 v = *(const u32x4*)(stg + row * 64 + ch * 8); __builtin_amdgcn_raw_buffer_store_b128(v, rmix, (int)(((rowbase + q0 + wid * 32 + row) * D + MIXOFF + h * 64 + ch * 8) * 2), 0, 16); } }
    asm volatile("s_waitcnt lgkmcnt(0)\n\ts_barrier" ::: "memory");
#undef SBA_DMA
}
}

constexpr int NWAVES = 8;
#ifndef MK_N_LAUNCHES
#define MK_N_LAUNCHES 1
#endif
constexpr int N_PHASES = 12;
constexpr size_t MiB = 1u << 20;
constexpr size_t WS_CTL = 0, CTL_ZERO_BYTES = 64 * 1024;
constexpr int CW_BAR = 4096;
constexpr size_t WS_SSPA = 1 * MiB, WS_SSPB = WS_SSPA + 256 * 1024, WS_BO = WS_SSPB + 256 * 1024;
constexpr size_t WS_WIN = 2 * MiB, WS_WOUT = 11 * MiB, WS_WUP = 15 * MiB, WS_WDN = 37 * MiB;
constexpr size_t WS_XB = 48 * MiB;
constexpr size_t WS_R = 81 * MiB, WS_PROJ = WS_R, WS_MIX = WS_R + 72 * MiB, WS_H = WS_R, WS_END = WS_R + 104 * MiB;
static_assert(WS_XB + (size_t)(M + 256) * D * 2 <= WS_R && WS_END <= 256 * MiB && WS_H + (size_t)M * DFF * 2 <= WS_END && WS_MIX + (size_t)M * D * 2 <= WS_END, "ws map");
constexpr int RING_OFF = 0, RING_BYTES = 131072, XL_OFF = RING_BYTES, LDSCTL_OFF = XL_OFF + 4096, MISC_OFF = LDSCTL_OFF + 320, LDS_BYTES = 147456;

struct Frame { LAS unsigned char* lds; volatile LAS unsigned* MISC; gu32* ctl; int tid, lane, wave, vcu, G; };
__device__ __forceinline__ float wave_sum(float v) { return pg8::wave_sum_all(v); }
__device__ __forceinline__ float bf2f(unsigned short b) { return __builtin_bit_cast(float, (unsigned)b << 16); }
__device__ __forceinline__ int map_in(int n) { const int t = n >> 8, j = n & 255; return (t < 2) ? ((j < 128) ? 128 * t + j : 256 + 128 * t + (j - 128)) : n; }
__device__ __forceinline__ int map_up(int n) { const int t = n >> 8, j = n & 255; return (j < 128) ? 128 * t + j : DFF + 128 * t + (j - 128); }

__device__ __forceinline__ void p0_transpose_item(const float* W, int K, int N, const float* g, bf16* WT, int src0, int n0, int k0, LAS float* scr, int lane, float cs = 1.0f) {
    float wv[32];
#pragma unroll
    for (int i = 0; i < 32; ++i) wv[i] = W[(size_t)(k0 + 2 * i + (lane >> 5)) * N + src0 + (lane & 31)];
    float gv[32];
    if (g) {
#pragma unroll
        for (int i = 0; i < 32; ++i) gv[i] = g[k0 + 2 * i + (lane >> 5)];
    } else {
#pragma unroll
        for (int i = 0; i < 32; ++i) gv[i] = 1.0f; }
#pragma unroll
    for (int i = 0; i < 32; ++i) { const int kk = 2 * i + (lane >> 5); scr[kk * 33 + (lane & 31)] = wv[i] * gv[i] * cs; }
    LDS_WAIT(); asm volatile("" ::: "memory");
    const int c = lane & 7;
#pragma unroll
    for (int j = 0; j < 4; ++j) { const int n = (lane >> 3) + 8 * j; const LAS float* s = scr + (8 * c) * 33 + n;
        v4u o; o.x = pk2(s[0 * 33], s[1 * 33]); o.y = pk2(s[2 * 33], s[3 * 33]); o.z = pk2(s[4 * 33], s[5 * 33]); o.w = pk2(s[6 * 33], s[7 * 33]);
        *(v4u*)(WT + (size_t)(n0 + n) * K + k0 + 8 * c) = o; }
    LDS_WAIT(); asm volatile("" ::: "memory");
}
struct Ptrs {
    const float *x, *norm1_g, *w_in, *cdw_w, *cdw_b, *cln_g, *cln_b, *cpw_w, *cpw_b, *pool_w, *pool_scale, *w_out, *norm2_g, *ffn_up, *fdw_w, *fdw_b, *ffn_down, *final_g;
    float* out; float *SSPA, *SSPB, *BO; bf16 *WIN, *WOUT, *WUP, *WDN, *XB, *PROJ, *MIX, *H;
};
__device__ __forceinline__ void p0_prologue(Frame& F, const Ptrs& P) {
    LAS float* scr = (LAS float*)(F.lds + RING_OFF + F.wave * 16384);
    const int gw = F.vcu * NWAVES + F.wave, NGW = F.G * NWAVES, lane = F.lane;
    constexpr int I_IN = 16 * 72, I_UP = 16 * 176, I_DN = 44 * 32, I_L = I_IN + I_UP + I_DN;
    for (int it = gw; it < DEPTH * I_L; it += NGW) {
        const int l = it / I_L; int r = it % I_L;
        if (r < I_IN) { const int kb = r / 72, nb = r % 72; p0_transpose_item(P.w_in + (size_t)l * D * DIN, D, DIN, P.norm1_g + l * D, P.WIN + (size_t)l * DIN * D, map_in(32 * nb), 32 * nb, 64 * kb, scr, lane, (32 * nb >= 768 && 32 * nb < 1280) ? 0.125f * 1.4426950408889634f : 1.0f); continue; } r -= I_IN;
        if (r < I_UP) { const int kb = r / 176, nb = r % 176; p0_transpose_item(P.ffn_up + (size_t)l * D * DUP, D, DUP, P.norm2_g + l * D, P.WUP + (size_t)l * DUP * D, map_up(32 * nb), 32 * nb, 64 * kb, scr, lane); continue; } r -= I_UP;
        { const int kb = r / 32, nb = r % 32; p0_transpose_item(P.ffn_down + (size_t)l * DFF * D, DFF, D, nullptr, P.WDN + (size_t)l * D * DFF, 32 * nb, 32 * nb, 64 * kb, scr, lane); }
    }
    for (int it = gw; it < DEPTH * 64 * 16; it += NGW) {
        const int l = it / 1024, kg = (it % 1024) / 16, nt = it % 16, k0 = 4 * kg, n = 64 * nt + lane;
        const float* wo = P.w_out + (size_t)l * D * D + n; const float* pw = P.cpw_w + (size_t)l * DCONV * DCONV + (size_t)k0 * DCONV; float acc[4] = {0.f, 0.f, 0.f, 0.f};
        for (int j0 = 0; j0 < 256; j0 += 32) { float wv[32];
#pragma unroll
            for (int u = 0; u < 32; ++u) wv[u] = wo[(size_t)(j0 + u) * D];
#pragma unroll
            for (int u = 0; u < 32; ++u)
#pragma unroll
                for (int i = 0; i < 4; ++i) acc[i] += pw[i * DCONV + j0 + u] * wv[u]; }
        *(unsigned long long*)(P.WOUT + (size_t)l * D * D + (size_t)n * D + k0) = (unsigned long long)pk2(acc[0], acc[1]) | ((unsigned long long)pk2(acc[2], acc[3]) << 32);
    }
    for (int it = gw; it < DEPTH * 64 * 16; it += NGW) {
        const int l = it / 1024, kg = (it % 1024) / 16, nt = it % 16, k0 = 256 + 4 * kg, n = 64 * nt + lane;
        const int g = (k0 - 256) >> 6, c0 = (k0 - 256) & 63; const float* pw = P.pool_w + (size_t)l * 4 * 64 * 64 + (size_t)(g * 64 + c0) * 64; const float* ps = P.pool_scale + l * DPOOL + 64 * g;
        const float* wo = P.w_out + (size_t)l * D * D + (size_t)(256 + 64 * g) * D + n; float acc[4] = {0.f, 0.f, 0.f, 0.f};
        for (int d0 = 0; d0 < 64; d0 += 8) { float wv[8];
#pragma unroll
            for (int u = 0; u < 8; ++u) wv[u] = ps[d0 + u] * wo[(size_t)(d0 + u) * D];
#pragma unroll
            for (int u = 0; u < 8; ++u)
#pragma unroll
                for (int i = 0; i < 4; ++i) acc[i] += pw[i * 64 + d0 + u] * wv[u]; }
        *(unsigned long long*)(P.WOUT + (size_t)l * D * D + (size_t)n * D + k0) = (unsigned long long)pk2(acc[0], acc[1]) | ((unsigned long long)pk2(acc[2], acc[3]) << 32);
    }
    for (int it = gw; it < DEPTH * 64 * 16; it += NGW) {
        const int l = it / 1024, kg = (it % 1024) / 16, nt = it % 16, k0 = 512 + 8 * kg, n = 64 * nt + lane;
        const float* wo = P.w_out + (size_t)l * D * D + n; float acc[8];
#pragma unroll
        for (int i = 0; i < 8; ++i) acc[i] = wo[(size_t)(k0 + i) * D];
        v4u o; o.x = pk2(acc[0], acc[1]); o.y = pk2(acc[2], acc[3]); o.z = pk2(acc[4], acc[5]); o.w = pk2(acc[6], acc[7]);
        *(v4u*)(P.WOUT + (size_t)l * D * D + (size_t)n * D + k0) = o;
    }
    for (int it = gw; it < DEPTH * 16; it += NGW) { const int l = it / 16, n = 64 * (it % 16) + lane; float acc = 0.f;
        for (int j = 0; j < 256; ++j) acc += P.cpw_b[l * DCONV + j] * P.w_out[(size_t)l * D * D + (size_t)j * D + n];
        P.BO[l * D + n] = acc; }
    for (int r0 = 4 * gw; r0 < M; r0 += 4 * NGW) {
        f32x4 v[4][4];
#pragma unroll
        for (int q = 0; q < 4; ++q)
#pragma unroll
            for (int j = 0; j < 4; ++j) v[q][j] = ((const f32x4*)(P.x + (size_t)(r0 + q) * D) + lane)[64 * j];
#pragma unroll
        for (int q = 0; q < 4; ++q) { float s = 0.f; unsigned long long* o = (unsigned long long*)(P.XB + (size_t)(r0 + q) * D) + lane;
#pragma unroll
            for (int j = 0; j < 4; ++j) { const f32x4 t = v[q][j]; s += (t.x * t.x + t.y * t.y) + (t.z * t.z + t.w * t.w); o[64 * j] = (unsigned long long)pk2(t.x, t.y) | ((unsigned long long)pk2(t.z, t.w) << 32); }
            s = wave_sum(s); if (lane == 0) *(f32x4*)(P.SSPB + (size_t)(r0 + q) * 4) = (f32x4){s, 0.f, 0.f, 0.f}; }
    }
}
__device__ __forceinline__ void convpool_unit(Frame& F, const Ptrs& P, int l, int t0) {
    bf16* Ul = (bf16*)(F.lds + RING_OFF); float* Y = (float*)(F.lds + RING_OFF + 94 * 256 * 2);
    LAS bf16* UlL = (LAS bf16*)(F.lds + RING_OFF); LAS float* YL = (LAS float*)(F.lds + RING_OFF + 94 * 256 * 2); (void)Ul; (void)Y;
    const int tid = F.tid, tl = t0 % SEQ; const bf16* PR = P.PROJ;
    { v4u av[6], gv[6];
#pragma unroll
      for (int k = 0; k < 6; ++k) { const int i = tid + 512 * k; const int r = i >> 5, ch = i & 31, c0 = ch * 8, tt = c0 >> 7, j = c0 & 127; const int tok = tl - 30 + r;
          const int rr = (r > 93 ? 93 : r), rowc = (tok >= 0) ? (t0 - 30 + rr) : t0;
          const bf16* rp = PR + (size_t)rowc * DIN + 256 * tt + j; av[k] = *(const v4u*)rp; gv[k] = *(const v4u*)(rp + 128);
          if (tok < 0) { av[k] = (v4u){0u, 0u, 0u, 0u}; gv[k] = av[k]; } }
#pragma unroll
      for (int k = 0; k < 6; ++k) { const int i = tid + 512 * k; const int r = i >> 5, ch = i & 31, c0 = ch * 8; unsigned ov[4];
#pragma unroll
          for (int q = 0; q < 4; ++q) { const unsigned aw = av[k][q], gw_ = gv[k][q];
              const float a0 = bf2f((unsigned short)(aw & 0xffff)), a1 = bf2f((unsigned short)(aw >> 16)), g0 = bf2f((unsigned short)(gw_ & 0xffff)), g1 = bf2f((unsigned short)(gw_ >> 16));
              ov[q] = pk2(a0 / (1.0f + __expf(-g0)), a1 / (1.0f + __expf(-g1))); }
          if (i < 94 * 32) *(LAS v4u*)(UlL + r * 256 + c0) = (v4u){ov[0], ov[1], ov[2], ov[3]}; } }
    __syncthreads();
    const int c = tid & 255, half = tid >> 8;
    const int tb = tl + half * 32; const bf16* pc = PR + 512 + c; unsigned short pv_[47];
#pragma unroll
    for (int k = 0; k < 47; ++k) { const int tok = tb - 15 + k; pv_[k] = pc[(size_t)(t0 + half * 32 + (tok >= 0 ? k - 15 : 0)) * DIN]; }
#pragma unroll
    for (int k = 0; k < 15; ++k) if (tb - 15 + k < 0) pv_[k] = (unsigned short)0;
    { const float* dw_w = P.cdw_w + (size_t)l * CONVK * DCONV; float w[CONVK];
#pragma unroll
      for (int i = 0; i < CONVK; ++i) w[i] = dw_w[i * DCONV + c];
      const float bb = P.cdw_b[l * DCONV + c];
#pragma unroll 1
      for (int g = 0; g < 2; ++g) { const int tbq = half * 32 + g * 16; float in[46];
#pragma unroll
          for (int i = 0; i < 46; ++i) in[i] = bf2f(UlL[(tbq + i) * 256 + c]);
#pragma unroll
          for (int q = 0; q < 16; ++q) { float acc = bb;
#pragma unroll
              for (int i = 0; i < CONVK; ++i) acc += w[i] * in[q + i];
              YL[(tbq + q) * 256 + c] = acc; } } }
    __syncthreads();
    { const int wv = F.wave, lane = F.lane; const f32x4 gg = ((const f32x4*)(P.cln_g + l * DCONV))[lane], bbv = ((const f32x4*)(P.cln_b + l * DCONV))[lane];
      f32x4 y[8]; float s1[8], s2[8];
#pragma unroll
      for (int q = 0; q < 8; ++q) { y[q] = ((const LAS f32x4*)(YL + (wv * 8 + q) * 256))[lane]; s1[q] = (y[q].x + y[q].y) + (y[q].z + y[q].w); }
#pragma unroll
      for (int q = 0; q < 8; ++q) s1[q] += pg8::swz_xor<1>(s1[q]);
#pragma unroll
      for (int q = 0; q < 8; ++q) s1[q] += pg8::swz_xor<2>(s1[q]);
#pragma unroll
      for (int q = 0; q < 8; ++q) s1[q] += pg8::swz_xor<4>(s1[q]);
#pragma unroll
      for (int q = 0; q < 8; ++q) s1[q] += pg8::swz_xor<8>(s1[q]);
#pragma unroll
      for (int q = 0; q < 8; ++q) s1[q] += pg8::swz_xor<16>(s1[q]);
#pragma unroll
      for (int q = 0; q < 8; ++q) { const float mu = pg8::add_xor32(s1[q]) * (1.0f / 256.0f); y[q] = y[q] - mu; s2[q] = (y[q].x * y[q].x + y[q].y * y[q].y) + (y[q].z * y[q].z + y[q].w * y[q].w); }
#pragma unroll
      for (int q = 0; q < 8; ++q) s2[q] += pg8::swz_xor<1>(s2[q]);
#pragma unroll
      for (int q = 0; q < 8; ++q) s2[q] += pg8::swz_xor<2>(s2[q]);
#pragma unroll
      for (int q = 0; q < 8; ++q) s2[q] += pg8::swz_xor<4>(s2[q]);
#pragma unroll
      for (int q = 0; q < 8; ++q) s2[q] += pg8::swz_xor<8>(s2[q]);
#pragma unroll
      for (int q = 0; q < 8; ++q) s2[q] += pg8::swz_xor<16>(s2[q]);
#pragma unroll
      for (int q = 0; q < 8; ++q) { const float rs = 1.0f / sqrtf(pg8::add_xor32(s2[q]) * (1.0f / 256.0f) + EPS);
          f32x4 z = y[q] * rs * gg + bbv; z.x = z.x / (1.0f + __expf(-z.x)); z.y = z.y / (1.0f + __expf(-z.y)); z.z = z.z / (1.0f + __expf(-z.z)); z.w = z.w / (1.0f + __expf(-z.w));
          *(unsigned long long*)(P.MIX + (size_t)(t0 + wv * 8 + q) * D + 4 * lane) = (unsigned long long)pk2(z.x, z.y) | ((unsigned long long)pk2(z.z, z.w) << 32); } }
    { const int win = 2 << (c >> 6);
#pragma unroll
      for (int q = 0; q < 32; ++q) { float s = 0.f;
#pragma unroll
          for (int j = 0; j < 16; ++j) s += (j < win) ? bf2f(pv_[15 + q - j]) : 0.f;
          const int tloc = tb + q; const int cnt = (tloc + 1 < win) ? tloc + 1 : win;
          P.MIX[(size_t)(t0 + half * 32 + q) * D + 256 + c] = (bf16)f2bf(s / (float)cnt - bf2f(pv_[15 + q])); } }
    __syncthreads();
}
__device__ __forceinline__ void mixers_phase(Frame& F, const Ptrs& P, int l) {
#ifdef DBG_MIX_T
    volatile LAS unsigned long long* TSm = (volatile LAS unsigned long long*)(F.lds + MISC_OFF + 256); if (blockIdx.x == 0 && F.tid == 0) TSm[38] = rt();
#endif
    for (int u = F.vcu; u < M / 64; u += F.G) convpool_unit(F, P, l, 64 * u);
#ifdef DBG_MIX_T
    if (blockIdx.x == 0 && F.tid == 0) { const unsigned long long t1 = rt(); TSm[36] += t1 - TSm[38]; TSm[38] = t1; }
#endif
    for (int k = 0; k < 2; ++k) for (int c = F.vcu; c < 256; c += F.G) { const int bh = c >> 2, j = c & 3, qb = k ? 7 - j : j;
        sba::attn_unit(bh >> 3, bh & 7, qb, P.PROJ, P.MIX, (char*)F.lds + RING_OFF, F.wave, F.lane); }
#ifdef DBG_MIX_T
    if (blockIdx.x == 0 && F.tid == 0) { TSm[37] += rt() - TSm[38]; }
#endif
}
__device__ __forceinline__ void final_phase(Frame& F, const Ptrs& P) {
    const int gw = F.vcu * NWAVES + F.wave, NGW = F.G * NWAVES, lane = F.lane;
    for (int r0 = 2 * gw; r0 < M; r0 += 2 * NGW) {
        v4u xb[2][2]; float r[2];
#pragma unroll
        for (int q = 0; q < 2; ++q) { xb[q][0] = ((const v4u*)(P.XB + (size_t)(r0 + q) * D))[lane]; xb[q][1] = ((const v4u*)(P.XB + (size_t)(r0 + q) * D))[64 + lane]; r[q] = pg8::rs_from_ssp(P.SSPB, r0 + q); }
#pragma unroll
        for (int q = 0; q < 2; ++q)
#pragma unroll
            for (int hf = 0; hf < 2; ++hf) { const f32x4* gr = (const f32x4*)(P.final_g + 512 * hf + 8 * lane); f32x4* o = (f32x4*)(P.out + (size_t)(r0 + q) * D + 512 * hf + 8 * lane); const v4u w = xb[q][hf];
                f32x4 a, b2; a[0] = __builtin_bit_cast(float, w[0] << 16); a[1] = __builtin_bit_cast(float, w[0] & 0xffff0000u); a[2] = __builtin_bit_cast(float, w[1] << 16); a[3] = __builtin_bit_cast(float, w[1] & 0xffff0000u);
                b2[0] = __builtin_bit_cast(float, w[2] << 16); b2[1] = __builtin_bit_cast(float, w[2] & 0xffff0000u); b2[2] = __builtin_bit_cast(float, w[3] << 16); b2[3] = __builtin_bit_cast(float, w[3] & 0xffff0000u);
                o[0] = a * r[q] * gr[0]; o[1] = b2 * r[q] * gr[1]; }
    }
}

#define MKP() Ptrs P; do { unsigned char* ws = args.ws; asm volatile("" : "+s"(ws)); P.x = args.in[0]; P.norm1_g = args.in[1]; P.w_in = args.in[2]; P.cdw_w = args.in[3]; P.cdw_b = args.in[4]; P.cln_g = args.in[5]; P.cln_b = args.in[6]; P.cpw_w = args.in[7]; P.cpw_b = args.in[8]; P.pool_w = args.in[9]; P.pool_scale = args.in[10]; P.w_out = args.in[11]; P.norm2_g = args.in[12]; P.ffn_up = args.in[13]; P.fdw_w = args.in[14]; P.fdw_b = args.in[15]; P.ffn_down = args.in[16]; P.final_g = args.in[17]; P.out = args.out; P.SSPA = (float*)(ws + WS_SSPA); P.SSPB = (float*)(ws + WS_SSPB); P.BO = (float*)(ws + WS_BO); P.WIN = (bf16*)(ws + WS_WIN); P.WOUT = (bf16*)(ws + WS_WOUT); P.WUP = (bf16*)(ws + WS_WUP); P.WDN = (bf16*)(ws + WS_WDN); P.XB = (bf16*)(ws + WS_XB); P.PROJ = (bf16*)(ws + WS_PROJ); P.MIX = (bf16*)(ws + WS_MIX); P.H = (bf16*)(ws + WS_H); } while (0)
struct Args { const float* in[18]; float* out; unsigned char* ws; int ph_lo, ph_hi; };
__global__ void __launch_bounds__(NWAVES * 64, 2) mega_fwd(Args args) {
    extern __shared__ __attribute__((aligned(16))) unsigned char lds[];
    Frame F;
    F.lds = (LAS unsigned char*)lds; F.MISC = (volatile LAS unsigned*)(F.lds + MISC_OFF);
    F.tid = threadIdx.x; F.lane = F.tid & 63; F.wave = __builtin_amdgcn_readfirstlane(F.tid >> 6);
    F.G = gridDim.x; { const int bx = blockIdx.x; F.vcu = (F.G % 8 == 0) ? (bx % 8) * (F.G / 8) + bx / 8 : bx; }
    F.ctl = (gu32*)(args.ws + WS_CTL);
    for (int u = F.tid; u < (LDS_BYTES - LDSCTL_OFF) / 4; u += NWAVES * 64) ((LAS unsigned*)(F.lds + LDSCTL_OFF))[u] = 0u;
    __syncthreads();
    const int lo = args.ph_lo, hi = args.ph_hi;
    const bool use_bar = (hi - lo) > 1;
    XcdBarrier bar; bar.bar = (unsigned*)(F.ctl + CW_BAR); bar.x = 0; bar.st = nullptr;
    if (use_bar) bar = xcd_barrier_post((unsigned*)(F.ctl + CW_BAR), F.MISC + 8);
#define REFRESH() do { int l_; asm volatile("v_mbcnt_lo_u32_b32 %0, -1, 0\n\tv_mbcnt_hi_u32_b32 %0, -1, %0" : "=v"(l_)); F.lane = l_; F.tid = 64 * F.wave + l_; } while (0)
#define LAUNDER_S(v) asm volatile("" : "+s"(v))
#ifdef DBG_TIMING
#ifndef DBG_GT_ST
#define DBG_GT_ST 3
#endif
    volatile LAS unsigned long long* TS = (volatile LAS unsigned long long*)(F.lds + MISC_OFF + 256);
    const bool stamper = (blockIdx.x == 0 && threadIdx.x == 0);
    if (stamper) { TS[0] = rt(); TS[16] = 0; TS[32] = 0; TS[33] = 0; TS[34] = 0; TS[35] = 0; TS[36] = 0; TS[37] = 0; }
#endif
#pragma nounroll
    for (int ph_ = lo; ph_ < hi; ++ph_) {
        int ph = ph_; LAUNDER_S(ph);
        const int l = (ph - 1) / 5, st = (ph == 0) ? -1 : (ph == N_PHASES - 1 ? 5 : (ph - 1) % 5);
        int bx = (int)blockIdx.x; LAUNDER_S(bx);
        MKP();
        if (st == -1) { REFRESH(); p0_prologue(F, P); }
        else if (st == 0) {
            pg8::Gemm g{P.XB, P.WIN + (size_t)l * DIN * D, M, DIN, D}; pg8::StaticOrder S; S.init(M, DIN, F.G, bx);
            pg8::EpiProj E{P.PROJ, DIN, P.SSPB};
            pg8::gemm_phase<pg8::EpiProj, pg8::StaticOrder, PG8_ALIGN, PG8_SP2>(F.lds + RING_OFF, g, S, E, F.wave); }
        else if (st == 1) { REFRESH(); mixers_phase(F, P, l); }
        else if (st == 2 || st == 4) {
            const bool o = (st == 2);
            pg8::Gemm g{o ? P.MIX : P.H, o ? P.WOUT + (size_t)l * D * D : P.WDN + (size_t)l * D * DFF, M, D, o ? D : DFF}; pg8::StaticOrder S; S.init(M, D, F.G, bx);
            pg8::EpiRes E{P.XB, o ? P.BO + l * D : nullptr, o ? P.SSPA : P.SSPB};
            pg8::gemm_phase<pg8::EpiRes, pg8::StaticOrder, false, PG8_SP2>(F.lds + RING_OFF, g, S, E, F.wave); }
        else if (st == 3) {
            pg8::Gemm g{P.XB, P.WUP + (size_t)l * DUP * D, M + 256, DUP, D}; pg8::StaticOrder S; S.init(M + 256, DUP, F.G, bx);
            pg8::EpiUp E{P.H, P.SSPA, P.fdw_w + (size_t)l * 3 * DFF, P.fdw_b + (size_t)l * DFF, (LAS float*)(F.lds + XL_OFF)};
            pg8::gemm_phase<pg8::EpiUp, pg8::StaticOrder, true, PG8_SP2>(F.lds + RING_OFF, g, S, E, F.wave); }
        else { REFRESH(); final_phase(F, P); }
#ifdef DBG_TIMING
        unsigned long long tb0 = 0; if (stamper) tb0 = rt();
#endif
        if (ph_ + 1 < hi) xcd_barrier(bar);
#ifdef DBG_TIMING
        if (stamper) { TS[ph_ + 1] = rt(); TS[16] += TS[ph_ + 1] - tb0;
            if (st == DBG_GT_ST) { TS[34] = TS[32]; TS[35] = TS[33]; } else { TS[32] = TS[34]; TS[33] = TS[35]; } }
#endif
    }
#ifdef DBG_TIMING
    if (stamper) { asm volatile("s_waitcnt vmcnt(0) lgkmcnt(0)" ::: "memory");
        float g[8];
        auto dd = [&](int k) { return (float)(TS[k + 1] - TS[k]) * 0.01f; };
        g[0] = dd(0); g[1] = dd(1) + dd(6); g[2] = dd(2) + dd(7); g[3] = dd(3) + dd(8); g[4] = dd(4) + dd(9); g[5] = dd(5) + dd(10); g[6] = dd(11); g[7] = (float)(TS[12] - TS[0]) * 0.01f;
        float g8 = (float)TS[16] * 0.01f, g9 = (float)TS[32] * 0.01f, g10 = (float)TS[33] * 0.01f;
#ifdef DBG_MIX_T
        g9 = (float)TS[36] * 0.01f; g10 = (float)TS[37] * 0.01f;
#endif (void)g8; (void)g9; (void)g10;
        args.out[0] = 0.25f * (DBG_SEL0 < 8 ? g[DBG_SEL0 & 7] : (DBG_SEL0 == 8 ? g8 : (DBG_SEL0 == 9 ? g9 : g10))); args.out[1] = 0.25f * (DBG_SEL1 < 8 ? g[DBG_SEL1 & 7] : (DBG_SEL1 == 8 ? g8 : (DBG_SEL1 == 9 ? g9 : g10))); }
#endif
}

extern "C" void kernel_launch(void* const* d_in, const int* in_sizes, int n_in, void* d_out, int out_size, void* d_ws, size_t ws_size, hipStream_t stream) {
    static int grid = 0;
    if (grid == 0) {
        if (n_in != 18 || in_sizes[0] != M * D || out_size != M * D || ws_size < WS_END) { fprintf(stderr, "kernel_launch: unexpected shapes (n_in %d, ws %zu)\n", n_in, ws_size); grid = -1; return; }
        int dev = 0, cus = 0, per_cu = 0;
        if (hipGetDevice(&dev) != hipSuccess || hipDeviceGetAttribute(&cus, hipDeviceAttributeMultiprocessorCount, dev) != hipSuccess) { grid = -1; return; }
        if (hipFuncSetAttribute((const void*)mega_fwd, hipFuncAttributeMaxDynamicSharedMemorySize, LDS_BYTES) != hipSuccess) { fprintf(stderr, "kernel_launch: hipFuncSetAttribute failed\n"); grid = -1; return; }
        if (hipOccupancyMaxActiveBlocksPerMultiprocessor(&per_cu, (const void*)mega_fwd, NWAVES * 64, LDS_BYTES) != hipSuccess || per_cu < 1) { fprintf(stderr, "kernel_launch: occupancy query says %d blocks per CU\n", per_cu); }
        (void)hipGetLastError();
        grid = cus;
        if (grid != 256) fprintf(stderr, "kernel_launch: %d CUs (the fused epilogues assume 256)\n", grid);
    }
    if (grid < 0) return;
    (void)hipMemsetAsync((char*)d_ws + WS_CTL, 0, CTL_ZERO_BYTES, stream);
    Args a{};
    for (int i = 0; i < 18; ++i) a.in[i] = (const float*)d_in[i];
    a.out = (float*)d_out; a.ws = (unsigned char*)d_ws;
    if (MK_N_LAUNCHES == 1) { a.ph_lo = 0; a.ph_hi = N_PHASES; hipLaunchKernelGGL(mega_fwd, dim3(grid), dim3(NWAVES * 64), LDS_BYTES, stream, a); }
    else for (int p = 0; p < N_PHASES; ++p) { a.ph_lo = p; a.ph_hi = p + 1; hipLaunchKernelGGL(mega_fwd, dim3(grid), dim3(NWAVES * 64), LDS_BYTES, stream, a); }
}
```
